# Optimizing an MI355X kernel written in HIP

```python
import jax, jax.numpy as jnp
from jax import lax
import numpy as np

D_MODEL = 1024
BATCH = 4
SEQ = 8192
DEPTH = 1

M_HEADS = 4
M_HEAD_DIM = 128
M_WIDTH = M_HEADS * M_HEAD_DIM
CONV_W = 4
CHUNK = 128
A_HEADS = 8
A_HEAD_DIM = 64
A_WIDTH = A_HEADS * A_HEAD_DIM
DIL_PATTERNS = ((128, 1), (512, 4), (2048, 16))
N_BUCKETS = 32
MAX_DISTANCE = 2048
MIX_WIDTH = M_WIDTH + A_WIDTH
IN_SIZES = (M_WIDTH, M_WIDTH, M_WIDTH, M_HEADS, M_HEADS, A_WIDTH, A_WIDTH, A_WIDTH)
IN_COLS = 3 * M_WIDTH + 2 * M_HEADS + 3 * A_WIDTH
PEER_HEADS = 8
N_KEYS = 128
N_EXPERTS = N_KEYS * N_KEYS
PEER_QDIM = 256
PEER_TOPK = 16
PEER_BLOCK = 128
EPS = 1e-6

kernel_name = 'hymba_mlstm_dilattn_peer_layer'


def rms_norm(x, g):
    xf = x.astype(jnp.float32)
    y = xf * lax.rsqrt(jnp.mean(xf * xf, axis=-1, keepdims=True) + EPS)
    return (y * g).astype(x.dtype)


def t5_bucket(dist):
    max_exact = N_BUCKETS // 2
    nf = jnp.maximum(dist, 1).astype(jnp.float32)
    large = max_exact + (jnp.log(nf / max_exact) / np.log(MAX_DISTANCE / max_exact)
                         * (N_BUCKETS - max_exact)).astype(jnp.int32)
    large = jnp.minimum(large, N_BUCKETS - 1)
    return jnp.where(dist < max_exact, dist, large)


def causal_short_conv(u, w, b):
    y = lax.conv_general_dilated(u, w[:, None, :], window_strides=(1,),
                                 padding=[(CONV_W - 1, 0)],
                                 dimension_numbers=('NWC', 'WIO', 'NWC'),
                                 feature_group_count=u.shape[-1])
    return y + b


def mlstm_chunkwise(q, k, v, ipre, fpre):
    B, H, S, Dh = q.shape
    nc = S // CHUNK
    q = q.reshape(B, H, nc, CHUNK, Dh)
    k = k.reshape(B, H, nc, CHUNK, Dh)
    v = v.reshape(B, H, nc, CHUNK, Dh)
    logi = ipre.reshape(B, H, nc, CHUNK)
    b = jnp.cumsum(jax.nn.log_sigmoid(fpre).reshape(B, H, nc, CHUNK), axis=-1)
    b_last = b[..., -1]
    g = b_last[..., None] - b + logi
    m_loc = jnp.max(g, axis=-1)
    wts = jnp.exp(g - m_loc[..., None])
    c_chunk = jnp.einsum('bhnl,bhnlk,bhnlv->bhnkv', wts, k, v)
    n_chunk = jnp.einsum('bhnl,bhnlk->bhnk', wts, k)

    def step(carry, inp):
        C, n, m = carry
        bl, ml, cc, nn = inp
        m_new = jnp.maximum(bl + m, ml)
        a = jnp.exp(bl + m - m_new)
        bb = jnp.exp(ml - m_new)
        C_new = a[..., None, None] * C + bb[..., None, None] * cc
        n_new = a[..., None] * n + bb[..., None] * nn
        return (C_new, n_new, m_new), (C, n, m)

    init = (jnp.zeros((B, H, Dh, Dh), jnp.float32), jnp.zeros((B, H, Dh), jnp.float32),
            jnp.zeros((B, H), jnp.float32))
    xs = (jnp.moveaxis(b_last, 2, 0), jnp.moveaxis(m_loc, 2, 0),
          jnp.moveaxis(c_chunk, 2, 0), jnp.moveaxis(n_chunk, 2, 0))
    _, (C_prev, n_prev, m_prev) = lax.scan(step, init, xs)
    C_prev = jnp.moveaxis(C_prev, 0, 2)
    n_prev = jnp.moveaxis(n_prev, 0, 2)
    m_prev = jnp.moveaxis(m_prev, 0, 2)

    causal = jnp.tril(jnp.ones((CHUNK, CHUNK), bool))
    log_d = jnp.where(causal, b[..., :, None] - b[..., None, :] + logi[..., None, :], -jnp.inf)
    inter = b + m_prev[..., None]
    m_t = jnp.maximum(inter, jnp.max(log_d, axis=-1))
    d_mat = jnp.exp(log_d - m_t[..., None])
    inter_w = jnp.exp(inter - m_t)
    s = jnp.einsum('bhnqd,bhnkd->bhnqk', q, k) * d_mat
    num = (jnp.einsum('bhnqk,bhnkd->bhnqd', s, v)
           + inter_w[..., None] * jnp.einsum('bhnqd,bhnde->bhnqe', q, C_prev))
    den = jnp.sum(s, axis=-1) + inter_w * jnp.einsum('bhnqd,bhnd->bhnq', q, n_prev)
    h = num / jnp.maximum(jnp.abs(den), jnp.exp(-m_t))[..., None]
    return h.reshape(B, H, S, Dh)


def dilated_branch(q, k, v, rel_bias, window, dilation):
    B, S, H, Dh = q.shape
    blk = window // dilation
    span = dilation * blk
    s_pad = -(-S // span) * span
    nb = s_pad // span

    def to_blocks(t):
        t = jnp.pad(t, ((0, 0), (0, s_pad - S), (0, 0), (0, 0)))
        return t.reshape(B, nb, blk, dilation, H, Dh).transpose(0, 3, 4, 1, 2, 5)

    qb, kb, vb = to_blocks(q), to_blocks(k), to_blocks(v)
    shift = lambda t: jnp.pad(t, ((0, 0), (0, 0), (0, 0), (1, 0), (0, 0), (0, 0)))[:, :, :, :-1]
    kk = jnp.concatenate([shift(kb), kb], axis=4)
    vv = jnp.concatenate([shift(vb), vb], axis=4)
    i = jnp.arange(blk)[:, None]
    j = jnp.arange(2 * blk)[None, :]
    steps = i + blk - j
    band = (steps >= 0) & (steps <= blk)
    valid = band[None] & ((jnp.arange(nb)[:, None, None] > 0) | (j >= blk)[None])
    bias = rel_bias[t5_bucket(jnp.maximum(steps, 0) * dilation)].transpose(2, 0, 1)
    s = (jnp.einsum('brhnqc,brhnkc->brhnqk', qb, kk).astype(jnp.float32) * (A_HEAD_DIM ** -0.5)
         + bias[None, None, :, None])
    s = jnp.where(valid[None, None, None], s, -jnp.inf)
    m = jnp.max(s, axis=-1, keepdims=True)
    p = jnp.exp(s - m)
    den = jnp.sum(p, axis=-1)
    o = jnp.einsum('brhnqk,brhnkc->brhnqc', p, vv) / den[..., None]
    lse = m[..., 0] + jnp.log(den)
    o = o.transpose(0, 3, 4, 1, 2, 5).reshape(B, s_pad, H, Dh)[:, :S]
    lse = lse.transpose(0, 3, 4, 1, 2).reshape(B, s_pad, H)[:, :S]
    return o, lse


def peer(h, w_query, sub_keys1, sub_keys2, expert_u, expert_v):
    B, S, D = h.shape
    T = B * S
    hf = h.reshape(T, D)
    q = (hf @ w_query).reshape(T, PEER_HEADS, 2, PEER_QDIM // 2)
    s1 = jnp.einsum('thc,hkc->thk', q[:, :, 0], sub_keys1).astype(jnp.float32)
    s2 = jnp.einsum('thc,hkc->thk', q[:, :, 1], sub_keys2).astype(jnp.float32)
    v1, i1 = lax.top_k(s1, PEER_TOPK)
    v2, i2 = lax.top_k(s2, PEER_TOPK)
    cand = (v1[..., :, None] + v2[..., None, :]).reshape(T, PEER_HEADS, PEER_TOPK * PEER_TOPK)
    vc, ic = lax.top_k(cand, PEER_TOPK)
    e1 = jnp.take_along_axis(i1, ic // PEER_TOPK, axis=-1)
    e2 = jnp.take_along_axis(i2, ic % PEER_TOPK, axis=-1)
    idx = (e1 * N_KEYS + e2).reshape(T, PEER_HEADS * PEER_TOPK)
    gate = jax.nn.softmax(vc, axis=-1).reshape(T, PEER_HEADS * PEER_TOPK)

    def block(args):
        xb, ib, gb = args
        u = expert_u[ib]
        pre = jnp.einsum('td,tkd->tk', xb, u).astype(jnp.float32)
        a = jax.nn.gelu(pre, approximate=False) * gb
        return jnp.einsum('tk,tkd->td', a, expert_v[ib])

    nblk = T // PEER_BLOCK
    out = lax.map(block, (hf.reshape(nblk, PEER_BLOCK, D),
                          idx.reshape(nblk, PEER_BLOCK, -1),
                          gate.reshape(nblk, PEER_BLOCK, -1)))
    return out.reshape(B, S, D).astype(h.dtype)


def setup_inputs(seed: int = 0) -> dict:
    key = jax.random.key(seed)
    ks = jax.random.split(key, 24)
    n = lambda i, shape: jax.random.normal(ks[i], shape, jnp.float32)
    return {
        'x': n(0, (BATCH, SEQ, D_MODEL)),
        'norm1_g': 1.0 + 0.02 * n(1, (DEPTH, D_MODEL)),
        'w_in': n(2, (DEPTH, D_MODEL, IN_COLS)) * D_MODEL ** -0.5,
        'conv_w': n(3, (DEPTH, CONV_W, M_WIDTH)) * CONV_W ** -0.5,
        'conv_b': 0.02 * n(4, (DEPTH, M_WIDTH)),
        'wq_m': n(5, (DEPTH, M_HEADS, M_HEAD_DIM, M_HEAD_DIM)) * M_HEAD_DIM ** -0.5,
        'wk_m': n(6, (DEPTH, M_HEADS, M_HEAD_DIM, M_HEAD_DIM)) * M_HEAD_DIM ** -0.5,
        'ig_b': 0.1 * n(7, (DEPTH, M_HEADS)),
        'fg_b': jnp.linspace(3.0, 6.0, M_HEADS, dtype=jnp.float32)[None] + 0.1 * n(8, (DEPTH, M_HEADS)),
        'mh_norm_g': 1.0 + 0.02 * n(9, (DEPTH, M_HEADS, M_HEAD_DIM)),
        'skip_m': 1.0 + 0.02 * n(10, (DEPTH, M_HEADS, M_HEAD_DIM)),
        'qn_g': 1.0 + 0.02 * n(11, (DEPTH, A_HEADS, A_HEAD_DIM)),
        'kn_g': 1.0 + 0.02 * n(12, (DEPTH, A_HEADS, A_HEAD_DIM)),
        'rel_bias': 0.5 * n(13, (N_BUCKETS, A_HEADS)),
        'w_out': n(14, (DEPTH, MIX_WIDTH, D_MODEL)) * MIX_WIDTH ** -0.5,
        'norm2_g': 1.0 + 0.02 * n(15, (DEPTH, D_MODEL)),
        'w_query': n(16, (DEPTH, D_MODEL, PEER_HEADS * PEER_QDIM)) * D_MODEL ** -0.5,
        'sub_keys1': n(17, (DEPTH, PEER_HEADS, N_KEYS, PEER_QDIM // 2)) * (PEER_QDIM // 2) ** -0.5,
        'sub_keys2': n(18, (DEPTH, PEER_HEADS, N_KEYS, PEER_QDIM // 2)) * (PEER_QDIM // 2) ** -0.5,
        'expert_u': n(19, (DEPTH, N_EXPERTS, D_MODEL)) * D_MODEL ** -0.5,
        'expert_v': n(20, (DEPTH, N_EXPERTS, D_MODEL)) * D_MODEL ** -0.5,
    }


def reference(x, norm1_g, w_in, conv_w, conv_b, wq_m, wk_m, ig_b, fg_b, mh_norm_g, skip_m,
              qn_g, kn_g, rel_bias, w_out, norm2_g, w_query, sub_keys1, sub_keys2,
              expert_u, expert_v):
    B, S, D = x.shape
    offsets = []
    acc = 0
    for sz in IN_SIZES[:-1]:
        acc += sz
        offsets.append(acc)
    for l in range(DEPTH):
        h = rms_norm(x, norm1_g[l])
        proj = h @ w_in[l]
        u, vm, z, ipre, fpre, qa, ka, va = jnp.split(proj, offsets, axis=-1)
        c = jax.nn.silu(causal_short_conv(u, conv_w[l], conv_b[l]))
        ch = c.reshape(B, S, M_HEADS, M_HEAD_DIM)
        qm = jnp.einsum('bshc,hcd->bhsd', ch, wq_m[l]).astype(jnp.float32)
        km = jnp.einsum('bshc,hcd->bhsd', ch, wk_m[l]).astype(jnp.float32) * (M_HEAD_DIM ** -0.5)
        vmh = vm.reshape(B, S, M_HEADS, M_HEAD_DIM).transpose(0, 2, 1, 3).astype(jnp.float32)
        ig = (ipre + ig_b[l]).astype(jnp.float32).transpose(0, 2, 1)
        fg = (fpre + fg_b[l]).astype(jnp.float32).transpose(0, 2, 1)
        hm = mlstm_chunkwise(qm, km, vmh, ig, fg).transpose(0, 2, 1, 3).astype(x.dtype)
        hm = rms_norm(hm, mh_norm_g[l]) + skip_m[l] * ch
        ym = jax.nn.sigmoid(z) * hm.reshape(B, S, M_WIDTH)
        qh = rms_norm(qa.reshape(B, S, A_HEADS, A_HEAD_DIM), qn_g[l])
        kh = rms_norm(ka.reshape(B, S, A_HEADS, A_HEAD_DIM), kn_g[l])
        vh = va.reshape(B, S, A_HEADS, A_HEAD_DIM)
        outs, lses = [], []
        for window, dilation in DIL_PATTERNS:
            o, lse = dilated_branch(qh, kh, vh, rel_bias, window, dilation)
            outs.append(o)
            lses.append(lse)
        wts = jax.nn.softmax(jnp.stack(lses, axis=0), axis=0)
        ya = jnp.sum(wts[..., None] * jnp.stack(outs, axis=0), axis=0)
        ya = ya.reshape(B, S, A_WIDTH).astype(x.dtype)
        x = x + jnp.concatenate([ym, ya], axis=-1) @ w_out[l]
        h2 = rms_norm(x, norm2_g[l])
        x = x + peer(h2, w_query[l], sub_keys1[l], sub_keys2[l], expert_u[l], expert_v[l])
    return x
```

```cpp
#include <hip/hip_runtime.h>
#include <cstdio>
#include <cstdint>

typedef unsigned short u16;
typedef short bf16x8 __attribute__((ext_vector_type(8)));
typedef short s16x4 __attribute__((ext_vector_type(4)));
typedef _Float16 f16x8 __attribute__((ext_vector_type(8)));
typedef _Float16 f16x2 __attribute__((ext_vector_type(2)));
typedef float f32x4 __attribute__((ext_vector_type(4)));

#define T_TOK 32768
#define SEQ 8192
#define DM 1024
#define MIB ((size_t)1 << 20)

#define OFF_WT_IN   ((size_t)0)
#define OFF_WT_OUT  (6 * MIB)
#define OFF_WT_Q    (8 * MIB)
#define OFF_WQM     (12 * MIB)
#define OFF_WKM     (12 * MIB + 128 * 1024)
#define OFF_SK1     (12 * MIB + 256 * 1024)
#define OFF_SK2     (12 * MIB + 512 * 1024)
#define OFF_GATES   (13 * MIB)
#define OFF_BCUM    (14 * MIB)
#define OFF_MLOC    (14 * MIB + 512 * 1024)
#define OFF_BLAST   (14 * MIB + 516 * 1024)
#define OFF_MPREV   (14 * MIB + 520 * 1024)
#define OFF_NCH     (15 * MIB)
#define OFF_NPREV   (15 * MIB + 512 * 1024)
#define OFF_LSE     (16 * MIB)
#define OFF_BAR     (19 * MIB)
#define OFF_R0      (24 * MIB)
#define OFF_R1      (88 * MIB)
#define OFF_R2      (280 * MIB)
#define OFF_R3      (312 * MIB)
#define OFF_R4      (376 * MIB)
#define WS_NEEDED   (504 * MIB)

#define OFF_H1   OFF_R0
#define OFF_CH   OFF_R0
#define OFF_QM   (OFF_R0 + 32 * MIB)
#define OFF_H2   OFF_R0
#define OFF_VM   (OFF_R1)
#define OFF_Z    (OFF_R1 + 32 * MIB)
#define OFF_U    (OFF_R1 + 64 * MIB)
#define OFF_QA   (OFF_R1 + 96 * MIB)
#define OFF_KA   (OFF_R1 + 128 * MIB)
#define OFF_VA   (OFF_R1 + 160 * MIB)
#define OFF_CPREV OFF_U
#define OFF_Y    OFF_QA
#define OFF_EU8  (472 * MIB)
#define OFF_EV8  (488 * MIB)
#define OFF_H2Q  OFF_Z
#define OFF_QP   OFF_U
#define OFF_KM   OFF_R2
#define OFF_PIDX OFF_R2
#define OFF_PGATE (OFF_R2 + 16 * MIB)
#define OFF_CCH  OFF_R3
#define OFF_ATTO OFF_R4
#define OFF_PPRE OFF_U
#define OFF_AW   OFF_R0
#define OFF_X1   OFF_R3

#define SMEM_BYTES 77824

struct Params {
    const float *x, *norm1_g, *w_in, *conv_w, *conv_b, *wq_m, *wk_m, *ig_b, *fg_b, *mh_norm_g, *skip_m,
        *qn_g, *kn_g, *rel_bias, *w_out, *norm2_g, *w_query, *sub_keys1, *sub_keys2, *expert_u, *expert_v;
    float* out;
    unsigned char* ws;
};

__device__ const unsigned char c_bucket[3][132] = {
{0,1,2,3,4,5,6,7,8,9,10,11,12,13,14,15,16,16,16,16,16,16,17,17,17,17,17,17,17,17,18,18,18,18,18,18,18,18,18,18,19,19,19,19,19,19,19,19,19,19,19,19,19,19,20,20,20,20,20,20,20,20,20,20,20,20,20,20,20,20,20,20,20,21,21,21,21,21,21,21,21,21,21,21,21,21,21,21,21,21,21,21,21,21,21,21,21,21,21,22,22,22,22,22,22,22,22,22,22,22,22,22,22,22,22,22,22,22,22,22,22,22,22,22,22,22,22,22,22,0,0,0},
{0,4,8,12,16,16,17,17,18,18,19,19,19,19,20,20,20,20,20,21,21,21,21,21,21,22,22,22,22,22,22,22,22,22,23,23,23,23,23,23,23,23,23,23,23,23,24,24,24,24,24,24,24,24,24,24,24,24,24,24,24,24,25,25,25,25,25,25,25,25,25,25,25,25,25,25,25,25,25,25,25,25,25,26,26,26,26,26,26,26,26,26,26,26,26,26,26,26,26,26,26,26,26,26,26,26,26,26,26,26,26,26,26,27,27,27,27,27,27,27,27,27,27,27,27,27,27,27,27,0,0,0},
{0,16,18,19,20,21,21,22,22,23,23,23,24,24,24,24,25,25,25,25,25,26,26,26,26,26,26,26,26,27,27,27,27,27,27,27,27,27,27,28,28,28,28,28,28,28,28,28,28,28,28,28,29,29,29,29,29,29,29,29,29,29,29,29,29,29,29,29,29,29,30,30,30,30,30,30,30,30,30,30,30,30,30,30,30,30,30,30,30,30,30,30,30,30,30,31,31,31,31,31,31,31,31,31,31,31,31,31,31,31,31,31,31,31,31,31,31,31,31,31,31,31,31,31,31,31,31,31,31,0,0,0}};

__device__ __forceinline__ float bf2f(u16 v) { return __uint_as_float(((unsigned)v) << 16); }
typedef __bf16 bf16x2_t __attribute__((ext_vector_type(2)));
typedef float f32x2_t __attribute__((ext_vector_type(2)));
__device__ __forceinline__ unsigned pk_bf16(float lo, float hi) {
    f32x2_t f; f.x = lo; f.y = hi;
    return __builtin_bit_cast(unsigned, __builtin_convertvector(f, bf16x2_t));
}
__device__ __forceinline__ u16 f2bf(float v) { return (u16)(pk_bf16(v, 0.f) & 0xffffu); }
__device__ __forceinline__ unsigned pk_f16(float lo, float hi) {
    f16x2 h; h.x = (_Float16)lo; h.y = (_Float16)hi; return __builtin_bit_cast(unsigned, h);
}
__device__ __forceinline__ float wave_sum(float v) {
#pragma unroll
    for (int o = 32; o > 0; o >>= 1) v += __shfl_xor(v, o);
    return v;
}
__device__ __forceinline__ float wave_max(float v) {
#pragma unroll
    for (int o = 32; o > 0; o >>= 1) v = fmaxf(v, __shfl_xor(v, o));
    return v;
}
__device__ __forceinline__ f32x4 mfma_bf16(bf16x8 a, bf16x8 b, f32x4 c) { return __builtin_amdgcn_mfma_f32_16x16x32_bf16(a, b, c, 0, 0, 0); }
__device__ __forceinline__ f32x4 mfma_f16(bf16x8 a, bf16x8 b, f32x4 c) {
    return __builtin_amdgcn_mfma_f32_16x16x32_f16(__builtin_bit_cast(f16x8, a), __builtin_bit_cast(f16x8, b), c, 0, 0, 0);
}

typedef float f32x2 __attribute__((ext_vector_type(2)));
__device__ __forceinline__ unsigned pk4_fp8(float a, float b, float c, float d) {
    int v = 0;
    v = __builtin_amdgcn_cvt_pk_fp8_f32(a, b, v, false);
    v = __builtin_amdgcn_cvt_pk_fp8_f32(c, d, v, true);
    return (unsigned)v;
}
__device__ __forceinline__ f32x4 mfma_fp8(long a, long b, f32x4 c) { return __builtin_amdgcn_mfma_f32_16x16x32_fp8_fp8(a, b, c, 0, 0, 0); }
__device__ __forceinline__ float sigmoidf_(float v) { return __builtin_amdgcn_rcpf(1.0f + __expf(-v)); }
__device__ __forceinline__ float log_sigmoid(float v) { return fminf(v, 0.f) - __logf(1.0f + __expf(-fabsf(v))); }
__device__ __forceinline__ void unpack8_bf16(uint4 v, float* f) {
    f[0] = __uint_as_float(v.x << 16); f[1] = __uint_as_float(v.x & 0xffff0000u);
    f[2] = __uint_as_float(v.y << 16); f[3] = __uint_as_float(v.y & 0xffff0000u);
    f[4] = __uint_as_float(v.z << 16); f[5] = __uint_as_float(v.z & 0xffff0000u);
    f[6] = __uint_as_float(v.w << 16); f[7] = __uint_as_float(v.w & 0xffff0000u);
}
typedef __attribute__((address_space(3))) s16x4 lds_s16x4;
__device__ __forceinline__ s16x4 ld_tr(const u16* p) { return __builtin_amdgcn_ds_read_tr16_b64_v4i16((lds_s16x4*)p); }
__device__ __forceinline__ bf16x8 cat4(s16x4 lo, s16x4 hi) { return __builtin_shufflevector(lo, hi, 0, 1, 2, 3, 4, 5, 6, 7); }


#define XB_TMO      128
#define XB_XCNT(j)  (256  + 64 * (j))
#define XB_XSUB(j)  (1280 + 64 * (j))
#define XB_XGEN(j)  (2304 + 64 * (j))
#define XB_TOP      3328
#define XB_TOPGEN   3392
#define XCD_BAR_WORDS 3456
#define XB_SPIN_CAP (1u << 22)
#define LAS __attribute__((address_space(3)))
__device__ __forceinline__ unsigned xb_ld(unsigned* p)              { return __hip_atomic_load(p, __ATOMIC_RELAXED, __HIP_MEMORY_SCOPE_AGENT); }
__device__ __forceinline__ unsigned xb_add(unsigned* p, unsigned v) { return __hip_atomic_fetch_add(p, v, __ATOMIC_RELAXED, __HIP_MEMORY_SCOPE_AGENT); }
__device__ __forceinline__ unsigned xb_xcc_id() { return (unsigned)__builtin_amdgcn_s_getreg((3 << 11) | 20) & 0xFu; }
#define XB_SPIN(cond, bar) do { unsigned _sp = 0; while (cond) { __builtin_amdgcn_s_sleep(1); \
    if ((++_sp & 255u) == 0u) { if (xb_ld(&(bar)[XB_TMO])) break; if (_sp > XB_SPIN_CAP) { atomicAdd(&(bar)[XB_TMO], 1u); break; } } } } while (0)
struct XcdBarrier { unsigned* bar; unsigned x; volatile unsigned* st; };
__device__ __forceinline__ XcdBarrier xcd_barrier_post(unsigned* bar, volatile unsigned* st) {
    XcdBarrier b; b.bar = bar; b.x = xb_xcc_id(); b.st = st;
    if (threadIdx.x == 0) (void)xb_add(&bar[XB_XCNT(b.x)], 1u);
    return b;
}
__device__ __forceinline__ void xcd_barrier_complete(unsigned* bar, unsigned x, unsigned& nloc, unsigned& nx) {
    const unsigned G = gridDim.x * gridDim.y * gridDim.z;
    unsigned sum, cnt, mine, sp = 0u;
    for (;;) {
        sum = 0u; cnt = 0u; mine = 0u;
#pragma unroll
        for (unsigned j = 0; j < 16; ++j) { const unsigned c = xb_ld(&bar[XB_XCNT(j)]); sum += c; cnt += (c > 0u) ? 1u : 0u; mine = (j == x) ? c : mine; }
        if (sum == G) break;
        __builtin_amdgcn_s_sleep(1);
        if ((++sp & 255u) == 0u) { if (xb_ld(&bar[XB_TMO])) break; if (sp > XB_SPIN_CAP) { atomicAdd(&bar[XB_TMO], 1u); break; } }
    }
    nloc = mine > 0u ? mine : 1u; nx = cnt > 0u ? cnt : 1u;
}
__device__ __forceinline__ void xcd_barrier(const XcdBarrier& b) {
    asm volatile("s_waitcnt vmcnt(0)" ::: "memory");
    __syncthreads();
    if (threadIdx.x == 0) {
        unsigned* bar = b.bar;
        __builtin_amdgcn_s_waitcnt(0);
        unsigned nloc = b.st[0], nx = b.st[1];
        if (nloc == 0u) { xcd_barrier_complete(bar, b.x, nloc, nx); b.st[0] = nloc; b.st[1] = nx; }
        const unsigned old = xb_add(&bar[XB_XSUB(b.x)], 1u);
        const unsigned gen = old / nloc;
        if (old + 1u == (gen + 1u) * nloc) {
            __builtin_amdgcn_fence(__ATOMIC_RELEASE, "agent");
            asm volatile("s_waitcnt vmcnt(0)" ::: "memory");
            const unsigned og = xb_add(&bar[XB_TOP], 1u);
            const unsigned tg = og / nx;
            if (og + 1u == (tg + 1u) * nx) xb_add(&bar[XB_TOPGEN], 1u);
            else XB_SPIN(xb_ld(&bar[XB_TOPGEN]) == tg, bar);
            __builtin_amdgcn_fence(__ATOMIC_ACQUIRE, "agent");
            xb_add(&bar[XB_XGEN(b.x)], 1u);
            asm volatile("s_waitcnt vmcnt(0)" ::: "memory");
        } else {
            XB_SPIN(xb_ld(&bar[XB_XGEN(b.x)]) == gen, bar);
            __builtin_amdgcn_fence(__ATOMIC_ACQUIRE, "agent");
            asm volatile("s_waitcnt vmcnt(0)" ::: "memory");
        }
    }
    __syncthreads();
}


#define TIDX ((int)(threadIdx.x & 255u))
#define HALFID ((int)(threadIdx.x >> 8))
#define VBID ((int)(blockIdx.x * 2u + (threadIdx.x >> 8)))
#define VGRID ((int)(gridDim.x * 2u))
#define SMEM_HALF 77824

namespace pg8 {
#define PG8_LAS __attribute__((address_space(3)))
typedef unsigned short bf16_t;
typedef short bf16x8 __attribute__((ext_vector_type(8)));
typedef float f32x4 __attribute__((ext_vector_type(4)));
typedef unsigned u32x4 __attribute__((ext_vector_type(4)));
constexpr int BM = 256, BK = 64, HALF = 128, HTB = HALF * BK * 2  , STAGE_BYTES = 8 * HTB, NXCD = 8, WGM = 8;

__host__ __device__ __forceinline__ int lds_byte(int r, int c) { const int st = (r >> 4) * 2 + (c >> 5), rr = r & 15, cc = c & 31, ob = rr * 64 + cc * 2; return st * 1024 + (ob ^ (((ob >> 9) & 1) << 5)); }
__host__ __device__ __forceinline__ void stage_rc(int b, int& R, int& C) { const int st = b / 1024, sb = b % 1024, swz = sb ^ (((sb >> 9) & 1) << 5); R = (st >> 1) * 16 + swz / 64; C = (st & 1) * 32 + (swz % 64) / 2; }
__host__ __device__ __forceinline__ int perm32(int rho) { const int n = rho >> 4, i = rho & 15; return 8 * (i >> 2) + 4 * n + (i & 3); }

struct Unit { int pm, pn; };
struct Gemm { const bf16_t* A; const bf16_t* Bt; int M, N, K; };

struct StaticOrder {
    int nM, nN, nwg, G, c;
    __host__ __device__ void init(int M, int N, int G_, int c_) { nM = M / BM; nN = N / BM; nwg = nM * nN; G = G_; c = c_; }
    __host__ __device__ bool next(int i, Unit& u) const {
        const long L = (long)i * G + c; if (L >= nwg) return false;
        int wgid = (int)L; { const int q = nwg / NXCD, r = nwg % NXCD, xcd = wgid % NXCD, off = wgid / NXCD; wgid = (xcd < r ? xcd * (q + 1) : r * (q + 1) + (xcd - r) * q) + off; }
        const int nig = WGM * nN, gid = wgid / nig, fm = gid * WGM, gsz = (nM - fm) < WGM ? (nM - fm) : WGM;
        u.pm = fm + ((wgid % nig) % gsz); u.pn = (wgid % nig) / gsz; return true;
    }
    __device__ __forceinline__ void a_ready(const Unit&) const {}
    __device__ __forceinline__ void done(const Unit&) const {}
};

__device__ __forceinline__ unsigned cvt_pk_bf16(float lo, float hi) { return ::pk_bf16(lo, hi); }
typedef float f32x2 __attribute__((ext_vector_type(2)));
__device__ __forceinline__ f32x2 gelu_pk(f32x2 v) {
    const f32x2 av = __builtin_elementwise_abs(v), d = av * 0.2316418882f + 1.0f;
    f32x2 t; t.x = __builtin_amdgcn_rcpf(d.x); t.y = __builtin_amdgcn_rcpf(d.y);
    f32x2 q = t * 0.5307027145f + (-0.7265760135f); q = q * t + 0.7107068705f; q = q * t + (-0.142248368f); q = q * t + 0.127414796f; q = q * t;
    const f32x2 s = (v * v) * (-0.72134752044f);
    f32x2 e; e.x = __builtin_amdgcn_exp2f(s.x); e.y = __builtin_amdgcn_exp2f(s.y);
    const f32x2 m = v * (q * e), r = v - m;
    f32x2 o; o.x = v.x < 0.f ? m.x : r.x; o.y = v.y < 0.f ? m.y : r.y; return o;
}
template <int ACT  > struct EpiBf16 {
    static constexpr bool PERM = true, AFTER_DRAIN = false; static_assert(ACT == 0 || ACT == 1, "EpiBf16: ACT is 0 (none) or 1 (gelu_pk)");
    bf16_t* O; int ldc; const float* bias; int split_cols; size_t split_stride; float scale0;
    __device__ __forceinline__ void operator()(const f32x4 (&acc)[2][2][4][2], const Unit& u, int wr, int wc, int fr, int fq) const {
        const int row0 = u.pm * BM + wr * 64 + fr; int colt = u.pn * BM; bf16_t* base = O;
        float sc = 1.f; if (split_cols) { const int t = colt / split_cols; base += (size_t)t * split_stride; colt -= t * split_cols; if (t == 0) sc = scale0; }
        const int col0 = colt + wc * 32 + 8 * fq, bcol0 = u.pn * BM + wc * 32 + 8 * fq;
        f32x4 bv[2][2];
#pragma unroll
        for (int bj = 0; bj < 2; ++bj)
#pragma unroll
            for (int n = 0; n < 2; ++n) bv[bj][n] = bias ? *(const f32x4*)(bias + bcol0 + bj * HALF + 4 * n) : (f32x4){0.f, 0.f, 0.f, 0.f};
#pragma unroll
        for (int ai = 0; ai < 2; ++ai)
#pragma unroll
            for (int m = 0; m < 4; ++m) { bf16_t* rowp = base + (size_t)(row0 + ai * HALF + m * 16) * ldc + col0;
#pragma unroll
                for (int bj = 0; bj < 2; ++bj) { f32x4 v0 = acc[ai][bj][m][0] + bv[bj][0], v1 = acc[ai][bj][m][1] + bv[bj][1];
                    if (ACT == 1) { f32x2 a = gelu_pk((f32x2){v0[0], v0[1]}), b = gelu_pk((f32x2){v0[2], v0[3]}), c = gelu_pk((f32x2){v1[0], v1[1]}), d = gelu_pk((f32x2){v1[2], v1[3]});
                        v0 = (f32x4){a.x, a.y, b.x, b.y}; v1 = (f32x4){c.x, c.y, d.x, d.y}; }
                    v0 = v0 * sc; v1 = v1 * sc; u32x4 w; w.x = cvt_pk_bf16(v0[0], v0[1]); w.y = cvt_pk_bf16(v0[2], v0[3]); w.z = cvt_pk_bf16(v1[0], v1[1]); w.w = cvt_pk_bf16(v1[2], v1[3]);
                    *(u32x4*)(rowp + bj * HALF) = w; } }
    }
};
template <class Epi, class Sched, bool ALIGN_EPI = false, bool SP2 = false>
__device__ __forceinline__ void gemm_phase(PG8_LAS unsigned char* lds, const Gemm g, const Sched& S, const Epi& E) {
    const int tid = threadIdx.x, wid = __builtin_amdgcn_readfirstlane(tid >> 6), lane = tid & 63, wr = wid >> 2, wc = wid & 3, fr = lane & 15, fq = lane >> 4;
    const int K = g.K, nt = K / BK;
    unsigned voffA[2], voffB[2];
#pragma unroll
    for (int i = 0; i < 2; ++i) { int R, C; stage_rc(tid * 16 + i * 8192, R, C); const int Rb = Epi::PERM ? ((R & ~31) + perm32(R & 31)) : R;
        voffA[i] = (unsigned)(R * K + C) * 2u; voffB[i] = (unsigned)(Rb * K + C) * 2u; }
    const size_t kstep = (size_t)(BK * 2);
    const size_t hstep = (size_t)HALF * K * 2;
    const size_t tstep = 2 * hstep;
    const unsigned ldsw = (unsigned)wid * 1024u;
    const int aoff = lds_byte(wr * 64 + fr, fq * 8), boff = lds_byte(wc * 32 + fr, fq * 8);
#define PG8_SA(b, h) (((b) * 2 + (h)) * HTB)
#define PG8_SB(b, h) ((4 + (b) * 2 + (h)) * HTB)
#define PG8_STAGE(bufoff, gbase, voff) do { _Pragma("unroll") for (int _i = 0; _i < 2; ++_i) \
        __builtin_amdgcn_global_load_lds((const unsigned*)((const char*)(gbase) + (voff)[_i]), (PG8_LAS unsigned*)(lds + (bufoff) + ldsw + _i * 8192), 16, 0, 0); } while (0)
#define PG8_LDA(dst, b, h) do { _Pragma("unroll") for (int m = 0; m < 4; ++m) _Pragma("unroll") for (int k = 0; k < 2; ++k) dst[m][k] = *(const PG8_LAS bf16x8*)(lds + PG8_SA(b, h) + aoff + m * 2048 + k * 1024); } while (0)
#define PG8_LDB(dst, b, h) do { _Pragma("unroll") for (int n = 0; n < 2; ++n) _Pragma("unroll") for (int k = 0; k < 2; ++k) dst[n][k] = *(const PG8_LAS bf16x8*)(lds + PG8_SB(b, h) + boff + n * 2048 + k * 1024); } while (0)
#define PG8_MMA(ai, bj, At, Bt) do { __builtin_amdgcn_s_setprio(1); _Pragma("unroll") for (int m = 0; m < 4; ++m) _Pragma("unroll") for (int n = 0; n < 2; ++n) _Pragma("unroll") for (int k = 0; k < 2; ++k) \
        acc[ai][bj][m][n] = __builtin_amdgcn_mfma_f32_16x16x32_bf16(Bt[n][k], At[m][k], acc[ai][bj][m][n], 0, 0, 0); __builtin_amdgcn_s_setprio(0); } while (0)
#define PG8_WAIT_V(n) asm volatile("s_waitcnt vmcnt(" #n ")" ::: "memory")
#define PG8_WAIT_L(n) asm volatile("s_waitcnt lgkmcnt(" #n ")" ::: "memory")
#define PG8_BAR __builtin_amdgcn_s_barrier()
#define PG8_SCHED __builtin_amdgcn_sched_barrier(0)
    Unit cur, nxt; int ui = 0;
    if (!S.next(0, cur)) return;
    f32x4 acc[2][2][4][2];
#pragma unroll
    for (int a = 0; a < 2; ++a)
#pragma unroll
        for (int b = 0; b < 2; ++b)
#pragma unroll
            for (int m = 0; m < 4; ++m)
#pragma unroll
                for (int n = 0; n < 2; ++n) acc[a][b][m][n] = (f32x4){0.f, 0.f, 0.f, 0.f};
    bf16x8 At[4][2], B0[2][2], B1[2][2];
    const char* cA = (const char*)g.A + (size_t)cur.pm * tstep; const char* cB = (const char*)g.Bt + (size_t)cur.pn * tstep;
    S.a_ready(cur);
    if constexpr (SP2) {
        PG8_STAGE(PG8_SB(0, 0), cB, voffB); PG8_STAGE(PG8_SB(0, 1), cB + hstep, voffB); PG8_STAGE(PG8_SA(0, 0), cA, voffA); PG8_STAGE(PG8_SA(0, 1), cA + hstep, voffA);
        if (wr == 1) PG8_BAR;
        PG8_WAIT_V(2); PG8_BAR;
        PG8_STAGE(PG8_SB(1, 0), cB + kstep, voffB); PG8_STAGE(PG8_SA(1, 0), cA + kstep, voffA); PG8_STAGE(PG8_SB(1, 1), cB + hstep + kstep, voffB);
        PG8_WAIT_V(6); PG8_BAR;
    } else {
        PG8_STAGE(PG8_SB(0, 0), cB, voffB); PG8_STAGE(PG8_SA(0, 0), cA, voffA); PG8_STAGE(PG8_SB(0, 1), cB + hstep, voffB); PG8_STAGE(PG8_SA(0, 1), cA + hstep, voffA);
        if (wr == 1) PG8_BAR;
        PG8_WAIT_V(4); PG8_BAR;
        PG8_STAGE(PG8_SB(1, 0), cB + kstep, voffB); PG8_STAGE(PG8_SA(1, 0), cA + kstep, voffA); PG8_STAGE(PG8_SB(1, 1), cB + hstep + kstep, voffB);
        PG8_WAIT_V(6); PG8_BAR;
    }
    for (;;) {
        const bool has_next = S.next(ui + 1, nxt);
        const char* nA = has_next ? (const char*)g.A + (size_t)nxt.pm * tstep : cA; const char* nB = has_next ? (const char*)g.Bt + (size_t)nxt.pn * tstep : cB;
        for (int t = 0; t < nt; t += 2) {
            const bool last = (t == nt - 2);
            const char* a1 = cA + (size_t)(t + 1) * kstep;
            const char* a2 = last ? nA : cA + (size_t)(t + 2) * kstep; const char* b2 = last ? nB : cB + (size_t)(t + 2) * kstep;
            const char* a3 = a2 + kstep; const char* b3 = b2 + kstep;
            if (last && has_next) S.a_ready(nxt);
            if constexpr (SP2) {
            PG8_LDB(B0, 0, 0); PG8_LDB(B1, 0, 1); PG8_SCHED; PG8_LDA(At, 0, 0); PG8_STAGE(PG8_SA(1, 1), a1 + hstep, voffA);
            PG8_WAIT_V(8); PG8_WAIT_L(0); PG8_BAR; PG8_MMA(0, 0, At, B0); PG8_MMA(0, 1, At, B1); PG8_BAR; PG8_SCHED;
            PG8_LDA(At, 0, 1); PG8_STAGE(PG8_SB(0, 0), b2, voffB); PG8_STAGE(PG8_SB(0, 1), b2 + hstep, voffB); PG8_STAGE(PG8_SA(0, 0), a2, voffA);
            PG8_WAIT_V(8); PG8_WAIT_L(0); PG8_BAR; PG8_MMA(1, 0, At, B0); PG8_MMA(1, 1, At, B1); PG8_BAR; PG8_SCHED;
            PG8_LDB(B0, 1, 0); PG8_LDB(B1, 1, 1); PG8_SCHED; PG8_LDA(At, 1, 0); PG8_STAGE(PG8_SA(0, 1), a2 + hstep, voffA);
            PG8_WAIT_V(8); PG8_WAIT_L(0); PG8_BAR; PG8_MMA(0, 0, At, B0); PG8_MMA(0, 1, At, B1); PG8_BAR; PG8_SCHED;
            PG8_LDA(At, 1, 1); PG8_STAGE(PG8_SB(1, 0), b3, voffB); PG8_STAGE(PG8_SB(1, 1), b3 + hstep, voffB); PG8_STAGE(PG8_SA(1, 0), a3, voffA);
            PG8_WAIT_V(8); PG8_WAIT_L(0); PG8_BAR; PG8_MMA(1, 0, At, B0); PG8_MMA(1, 1, At, B1); PG8_BAR; PG8_SCHED;
            } else {
            PG8_LDB(B0, 0, 0); PG8_SCHED; PG8_LDA(At, 0, 0); PG8_STAGE(PG8_SA(1, 1), a1 + hstep, voffA);
            PG8_WAIT_L(8); PG8_BAR; PG8_WAIT_L(0); PG8_MMA(0, 0, At, B0); PG8_BAR; PG8_SCHED;
            PG8_LDB(B1, 0, 1); PG8_STAGE(PG8_SB(0, 0), b2, voffB);
            PG8_BAR; PG8_WAIT_L(0); PG8_MMA(0, 1, At, B1); PG8_BAR;
            PG8_LDA(At, 0, 1); PG8_STAGE(PG8_SA(0, 0), a2, voffA);
            PG8_BAR; PG8_WAIT_L(0); PG8_MMA(1, 0, At, B0); PG8_BAR; PG8_SCHED;
            PG8_STAGE(PG8_SB(0, 1), b2 + hstep, voffB);
            PG8_WAIT_V(6); PG8_BAR; PG8_MMA(1, 1, At, B1); PG8_BAR;
            PG8_LDB(B0, 1, 0); PG8_SCHED; PG8_LDA(At, 1, 0); PG8_STAGE(PG8_SA(0, 1), a2 + hstep, voffA);
            PG8_WAIT_L(8); PG8_BAR; PG8_WAIT_L(0); PG8_MMA(0, 0, At, B0); PG8_BAR; PG8_SCHED;
            PG8_LDB(B1, 1, 1); PG8_STAGE(PG8_SB(1, 0), b3, voffB);
            PG8_BAR; PG8_WAIT_L(0); PG8_MMA(0, 1, At, B1); PG8_BAR;
            PG8_LDA(At, 1, 1); PG8_STAGE(PG8_SA(1, 0), a3, voffA);
            PG8_BAR; PG8_WAIT_L(0); PG8_MMA(1, 0, At, B0); PG8_BAR; PG8_SCHED;
            PG8_STAGE(PG8_SB(1, 1), b3 + hstep, voffB);
            PG8_WAIT_V(6); PG8_BAR; PG8_MMA(1, 1, At, B1); PG8_BAR;
            }
        }
        if constexpr (ALIGN_EPI) { if (wr == 0) PG8_BAR; }
        if constexpr (!Epi::AFTER_DRAIN) { E(acc, cur, wr, wc, fr, fq); S.done(cur); }
        if (!has_next) break;
#pragma unroll
        for (int a = 0; a < 2; ++a)
#pragma unroll
            for (int b = 0; b < 2; ++b)
#pragma unroll
                for (int m = 0; m < 4; ++m)
#pragma unroll
                    for (int n = 0; n < 2; ++n) acc[a][b][m][n] = (f32x4){0.f, 0.f, 0.f, 0.f};
        cur = nxt; cA = nA; cB = nB; ++ui;
        if constexpr (ALIGN_EPI) { if (wr == 1) PG8_BAR; }
    }
    PG8_WAIT_V(0);
    if constexpr (!ALIGN_EPI) { if (wr == 0) PG8_BAR; }
    PG8_BAR;
    if constexpr (Epi::AFTER_DRAIN) { E.fused(acc, cur, wr, wc, fr, fq, lds, wid, lane); S.done(cur); }
#undef PG8_SA
#undef PG8_SB
#undef PG8_STAGE
#undef PG8_LDA
#undef PG8_LDB
#undef PG8_MMA
#undef PG8_WAIT_V
#undef PG8_WAIT_L
#undef PG8_BAR
#undef PG8_SCHED
}

struct EpiResF32 {
    static constexpr bool PERM = false, AFTER_DRAIN = false;
    const float* base; float* out; int ldc;
    __device__ __forceinline__ void operator()(const f32x4 (&acc)[2][2][4][2], const Unit& u, int wr, int wc, int fr, int fq) const {
        const int col0 = u.pn * BM + wc * 32 + 4 * fq;
#pragma unroll
        for (int ai = 0; ai < 2; ++ai)
#pragma unroll
            for (int m = 0; m < 4; ++m) {
                const size_t off = (size_t)(u.pm * BM + ai * HALF + wr * 64 + m * 16 + fr) * ldc + col0;
#pragma unroll
                for (int bj = 0; bj < 2; ++bj)
#pragma unroll
                    for (int n = 0; n < 2; ++n) {
                        const f32x4 bs = *(const f32x4*)(base + off + bj * HALF + n * 16);
                        *(f32x4*)(out + off + bj * HALF + n * 16) = bs + acc[ai][bj][m][n];
                    }
            }
    }
};
struct EpiF16 {
    static constexpr bool PERM = true, AFTER_DRAIN = false;
    bf16_t* O; int ldc;
    __device__ __forceinline__ void operator()(const f32x4 (&acc)[2][2][4][2], const Unit& u, int wr, int wc, int fr, int fq) const {
        const int row0 = u.pm * BM + wr * 64 + fr, col0 = u.pn * BM + wc * 32 + 8 * fq;
#pragma unroll
        for (int ai = 0; ai < 2; ++ai)
#pragma unroll
            for (int m = 0; m < 4; ++m) {
                bf16_t* rowp = O + (size_t)(row0 + ai * HALF + m * 16) * ldc + col0;
#pragma unroll
                for (int bj = 0; bj < 2; ++bj) {
                    const f32x4 v0 = acc[ai][bj][m][0], v1 = acc[ai][bj][m][1];
                    u32x4 w; w.x = ::pk_f16(v0[0], v0[1]); w.y = ::pk_f16(v0[2], v0[3]); w.z = ::pk_f16(v1[0], v1[1]); w.w = ::pk_f16(v1[2], v1[3]);
                    *(u32x4*)(rowp + bj * HALF) = w;
                }
            }
    }
};
}

#define P0_NTR 1632
#define P0_ITEMS (P0_NTR + T_TOK / 8)

__device__ __forceinline__ void tr_tile(const float* __restrict__ src, int ld_src, int k0, int c0, u16* __restrict__ dst, int ld_dst, int n0,
                                        float scale, bool f16, float* tile) {
    const int tid = TIDX;
#pragma unroll
    for (int i = 0; i < 4; ++i) {
        const int idx = tid + 256 * i, r = idx >> 4, c = (idx & 15) * 4;
        const float4 v = *(const float4*)(src + (size_t)(k0 + r) * ld_src + c0 + c);
        tile[r * 65 + c] = v.x * scale; tile[r * 65 + c + 1] = v.y * scale; tile[r * 65 + c + 2] = v.z * scale; tile[r * 65 + c + 3] = v.w * scale;
    }
    __syncthreads();
#pragma unroll
    for (int i = 0; i < 8; ++i) {
        const int idx = tid + 256 * i, c = idx >> 5, r = (idx & 31) * 2;
        const float a = tile[r * 65 + c], b = tile[(r + 1) * 65 + c];
        const unsigned w = f16 ? pk_f16(a, b) : pk_bf16(a, b);
        *(unsigned*)(dst + (size_t)(n0 + c) * ld_dst + k0 + r) = w;
    }
    __syncthreads();
}

__device__ void phase0(const Params& p, unsigned char* smem) {
    int tid_ = TIDX; asm volatile("" : "+v"(tid_)); const int tid = tid_, lane = tid & 63, wave = __builtin_amdgcn_readfirstlane(tid >> 6);
    float* tile = (float*)smem;
    float* sG = (float*)(smem + 17408);
    bool staged = false;
    for (int item = VBID; item < P0_ITEMS; item += VGRID) {
        if (item < P0_NTR) {
            int it = item;
            if (it < 768) {
                const int kt = it & 15, nt = it >> 4, n0 = nt * 64, arr = n0 >> 9, within = n0 & 511;
                const int srcc = (arr == 0 ? 512 : arr == 1 ? 1024 : arr == 2 ? 0 : arr == 3 ? 1544 : arr == 4 ? 2056 : 2568) + within;
                tr_tile(p.w_in, 3080, kt * 64, srcc, (u16*)(p.ws + OFF_WT_IN), 1024, n0, 1.0f, false, tile);
                continue;
            }
            it -= 768;
            if (it < 256) { tr_tile(p.w_out, 1024, (it & 15) * 64, (it >> 4) * 64, (u16*)(p.ws + OFF_WT_OUT), 1024, (it >> 4) * 64, 1.0f, false, tile); continue; }
            it -= 256;
            if (it < 512) { tr_tile(p.w_query, 2048, (it & 15) * 64, (it >> 4) * 64, (u16*)(p.ws + OFF_WT_Q), 1024, (it >> 4) * 64, 1.0f, false, tile); continue; }
            it -= 512;
            if (it < 32) {
                const int which = it >> 4, hh = (it >> 2) & 3, kt = (it >> 1) & 1, nt = it & 1;
                const float* src = (which ? p.wk_m : p.wq_m) + hh * 16384;
                u16* dst = (u16*)(p.ws + (which ? OFF_WKM : OFF_WQM)) + hh * 16384;
                tr_tile(src, 128, kt * 64, nt * 64, dst, 128, nt * 64, which ? 0.08838834764831845f : 1.0f, false, tile);
                continue;
            }
            it -= 32;
            {
                const int which = it >> 5, part = it & 31;
                const float* src = (which ? p.sub_keys2 : p.sub_keys1) + part * 4096;
                u16* dst = (u16*)(p.ws + (which ? OFF_SK2 : OFF_SK1)) + part * 4096;
#pragma unroll
                for (int i = 0; i < 4; ++i) {
                    const int e = (tid + 256 * i) * 4;
                    const float4 v = *(const float4*)(src + e);
                    uint2 w; w.x = pk_f16(v.x, v.y); w.y = pk_f16(v.z, v.w);
                    *(uint2*)(dst + e) = w;
                }
            }
            continue;
        }
        if (!staged) {
            for (int i = tid; i < 1024 * 2; i += 256) {
                const int k = i >> 1, hf = i & 1, slot = ((k >> 8) * 4 + (k & 3)) * 64 + ((k >> 2) & 63);
                *(float4*)(sG + hf * 4096 + slot * 4) = *(const float4*)(p.w_in + (size_t)k * 3080 + 1536 + hf * 4);
            }
            __syncthreads();
            staged = true;
        }
        const int row0 = (item - P0_NTR) * 8 + wave * 2;
        float4 v[2][4];
        float ss[2] = {0.f, 0.f};
#pragma unroll
        for (int rr = 0; rr < 2; ++rr) {
            const float4* xr = (const float4*)(p.x + (size_t)(row0 + rr) * DM);
#pragma unroll
            for (int j = 0; j < 4; ++j) v[rr][j] = xr[lane + 64 * j];
        }
#pragma unroll
        for (int rr = 0; rr < 2; ++rr)
#pragma unroll
            for (int j = 0; j < 4; ++j) ss[rr] += v[rr][j].x * v[rr][j].x + v[rr][j].y * v[rr][j].y + v[rr][j].z * v[rr][j].z + v[rr][j].w * v[rr][j].w;
        ss[0] = wave_sum(ss[0]); ss[1] = wave_sum(ss[1]);
        {
            const float rs0 = rsqrtf(ss[0] * (1.0f / 1024.0f) + 1e-6f), rs1 = rsqrtf(ss[1] * (1.0f / 1024.0f) + 1e-6f);
            float ga[2][8];
#pragma unroll
            for (int c = 0; c < 8; ++c) { ga[0][c] = 0.f; ga[1][c] = 0.f; }
            u16* h1a = (u16*)(p.ws + OFF_H1) + (size_t)row0 * DM;
#pragma unroll
            for (int j = 0; j < 4; ++j) {
                const float4 g = ((const float4*)p.norm1_g)[lane + 64 * j];
                const float ya[4] = {v[0][j].x * rs0 * g.x, v[0][j].y * rs0 * g.y, v[0][j].z * rs0 * g.z, v[0][j].w * rs0 * g.w};
                const float yb[4] = {v[1][j].x * rs1 * g.x, v[1][j].y * rs1 * g.y, v[1][j].z * rs1 * g.z, v[1][j].w * rs1 * g.w};
                uint2 w; w.x = pk_bf16(ya[0], ya[1]); w.y = pk_bf16(ya[2], ya[3]);
                *(uint2*)(h1a + 4 * (lane + 64 * j)) = w;
                w.x = pk_bf16(yb[0], yb[1]); w.y = pk_bf16(yb[2], yb[3]);
                *(uint2*)(h1a + DM + 4 * (lane + 64 * j)) = w;
#pragma unroll
                for (int e = 0; e < 4; ++e) {
                    const float4 g0 = *(const float4*)(sG + ((j * 4 + e) * 64 + lane) * 4), g1 = *(const float4*)(sG + 4096 + ((j * 4 + e) * 64 + lane) * 4);
                    ga[0][0] += ya[e] * g0.x; ga[0][1] += ya[e] * g0.y; ga[0][2] += ya[e] * g0.z; ga[0][3] += ya[e] * g0.w;
                    ga[0][4] += ya[e] * g1.x; ga[0][5] += ya[e] * g1.y; ga[0][6] += ya[e] * g1.z; ga[0][7] += ya[e] * g1.w;
                    ga[1][0] += yb[e] * g0.x; ga[1][1] += yb[e] * g0.y; ga[1][2] += yb[e] * g0.z; ga[1][3] += yb[e] * g0.w;
                    ga[1][4] += yb[e] * g1.x; ga[1][5] += yb[e] * g1.y; ga[1][6] += yb[e] * g1.z; ga[1][7] += yb[e] * g1.w;
                }
                asm volatile("" ::: "memory");
            }
#pragma unroll
            for (int rr = 0; rr < 2; ++rr) {
#pragma unroll
                for (int c = 0; c < 8; ++c) ga[rr][c] = wave_sum(ga[rr][c]);
                if (lane == 0) {
                    float* G = (float*)(p.ws + OFF_GATES) + (size_t)(row0 + rr) * 8;
                    float4 o0, o1;
                    o0.x = ga[rr][0] + p.ig_b[0]; o0.y = ga[rr][1] + p.ig_b[1]; o0.z = ga[rr][2] + p.ig_b[2]; o0.w = ga[rr][3] + p.ig_b[3];
                    o1.x = log_sigmoid(ga[rr][4] + p.fg_b[0]); o1.y = log_sigmoid(ga[rr][5] + p.fg_b[1]); o1.z = log_sigmoid(ga[rr][6] + p.fg_b[2]); o1.w = log_sigmoid(ga[rr][7] + p.fg_b[3]);
                    *(float4*)G = o0; *(float4*)(G + 4) = o1;
                }
            }
        }
    }
    __syncthreads();
}

template <int MODE>
__device__ void gemm_tile(const Params& p, const u16* __restrict__ A, const u16* __restrict__ Bt, const int K, const int m0, const int n0, unsigned char* smem) {
    u16* sA = (u16*)smem;
    u16* sB = sA + 2 * 128 * 72;
    int tid_ = TIDX; asm volatile("" : "+v"(tid_)); const int tid = tid_, lane = tid & 63, wave = __builtin_amdgcn_readfirstlane(tid >> 6), fr = lane & 15, fq = lane >> 4, wm = wave >> 1, wn = wave & 1;
    f32x4 acc[4][4];
#pragma unroll
    for (int i = 0; i < 4; ++i)
#pragma unroll
        for (int j = 0; j < 4; ++j) acc[i][j] = (f32x4){0.f, 0.f, 0.f, 0.f};
    uint4 ra[4], rb[4];
    const int crow = tid >> 3, ccol = (tid & 7) * 8;
    const u16* gA = A + (size_t)(m0 + crow) * K + ccol;
    const u16* gB = Bt + (size_t)(n0 + crow) * K + ccol;
#pragma unroll
    for (int i = 0; i < 4; ++i) { ra[i] = *(const uint4*)(gA + (size_t)(32 * i) * K); rb[i] = *(const uint4*)(gB + (size_t)(32 * i) * K); }
#pragma unroll
    for (int i = 0; i < 4; ++i) { *(uint4*)(sA + (crow + 32 * i) * 72 + ccol) = ra[i]; *(uint4*)(sB + (crow + 32 * i) * 72 + ccol) = rb[i]; }
    __syncthreads();
    const int nk = K >> 6;
    for (int kt = 0; kt < nk; ++kt) {
        if (kt + 1 < nk) {
#pragma unroll
            for (int i = 0; i < 4; ++i) { ra[i] = *(const uint4*)(gA + (size_t)(32 * i) * K + (kt + 1) * 64); rb[i] = *(const uint4*)(gB + (size_t)(32 * i) * K + (kt + 1) * 64); }
        }
        const u16* a = sA + (kt & 1) * 128 * 72;
        const u16* b = sB + (kt & 1) * 128 * 72;
#pragma unroll
        for (int ks = 0; ks < 2; ++ks) {
            bf16x8 af[4], bfr[4];
#pragma unroll
            for (int mi = 0; mi < 4; ++mi) af[mi] = *(const bf16x8*)(a + (wm * 64 + mi * 16 + fr) * 72 + ks * 32 + fq * 8);
#pragma unroll
            for (int ni = 0; ni < 4; ++ni) bfr[ni] = *(const bf16x8*)(b + (wn * 64 + ni * 16 + fr) * 72 + ks * 32 + fq * 8);
#pragma unroll
            for (int mi = 0; mi < 4; ++mi)
#pragma unroll
                for (int ni = 0; ni < 4; ++ni) {
                    if (MODE == 2) acc[mi][ni] = mfma_f16(bfr[ni], af[mi], acc[mi][ni]);
                    else acc[mi][ni] = mfma_bf16(bfr[ni], af[mi], acc[mi][ni]);
                }
        }
        if (kt + 1 < nk) {
            u16* a2 = sA + ((kt + 1) & 1) * 128 * 72;
            u16* b2 = sB + ((kt + 1) & 1) * 128 * 72;
#pragma unroll
            for (int i = 0; i < 4; ++i) { *(uint4*)(a2 + (crow + 32 * i) * 72 + ccol) = ra[i]; *(uint4*)(b2 + (crow + 32 * i) * 72 + ccol) = rb[i]; }
        }
        __syncthreads();
    }
#pragma unroll
    for (int mi = 0; mi < 4; ++mi) {
        const size_t row = (size_t)(m0 + wm * 64 + mi * 16 + fr);
#pragma unroll
        for (int ni = 0; ni < 4; ++ni) {
            const int col = n0 + wn * 64 + ni * 16 + 4 * fq;
            const f32x4 c = acc[mi][ni];
            if (MODE == 0) {
                const int arr = col >> 9, within = col & 511;
                u16* dst = (u16*)(p.ws + OFF_R1 + (size_t)arr * 32 * MIB) + row * 512 + within;
                uint2 w; w.x = pk_bf16(c[0], c[1]); w.y = pk_bf16(c[2], c[3]);
                *(uint2*)dst = w;
            } else if (MODE == 1) {
                const float4 xin = *(const float4*)(p.x + row * DM + col);
                float4 o; o.x = xin.x + c[0]; o.y = xin.y + c[1]; o.z = xin.z + c[2]; o.w = xin.w + c[3];
                *(float4*)((float*)(p.ws + OFF_X1) + row * DM + col) = o;
            } else {
                u16* dst = (u16*)(p.ws + OFF_QP) + row * 2048 + col;
                uint2 w; w.x = pk_f16(c[0], c[1]); w.y = pk_f16(c[2], c[3]);
                *(uint2*)dst = w;
            }
        }
    }
}

__device__ void mlstm_local(const Params& p, const int item, unsigned char* smem) {
    int tid_ = TIDX; asm volatile("" : "+v"(tid_)); const int tid = tid_, lane = tid & 63, wave = __builtin_amdgcn_readfirstlane(tid >> 6), fr = lane & 15, fq = lane >> 4;
    const int b = item >> 8, h = (item >> 6) & 3, n = item & 63;
    const size_t t0 = (size_t)b * SEQ + (size_t)n * 128;
    u16* sC = (u16*)smem;
    u16* sKT = sC + 128 * 136;
    float* sW = (float*)(sKT + 128 * 136);
    const u16* U = (const u16*)(p.ws + OFF_U);
    u16* CH = (u16*)(p.ws + OFF_CH);
    {
        const int cc = tid & 15, rg = tid >> 4, col = h * 128 + cc * 8;
        const int s0 = n * 128 + rg * 8;
        const u16* ub = U + ((size_t)b * SEQ) * 512 + col;
        uint4 ur[11];
#pragma unroll
        for (int j = 0; j < 11; ++j) {
            const int sp = s0 - 3 + j;
            ur[j] = (sp >= 0) ? *(const uint4*)(ub + (size_t)sp * 512) : make_uint4(0, 0, 0, 0);
        }
        float wv[4][8], bv[8];
#pragma unroll
        for (int k = 0; k < 4; ++k) {
            const float4 a = *(const float4*)(p.conv_w + k * 512 + col), c2 = *(const float4*)(p.conv_w + k * 512 + col + 4);
            wv[k][0] = a.x; wv[k][1] = a.y; wv[k][2] = a.z; wv[k][3] = a.w; wv[k][4] = c2.x; wv[k][5] = c2.y; wv[k][6] = c2.z; wv[k][7] = c2.w;
        }
        { const float4 a = *(const float4*)(p.conv_b + col), c2 = *(const float4*)(p.conv_b + col + 4);
          bv[0] = a.x; bv[1] = a.y; bv[2] = a.z; bv[3] = a.w; bv[4] = c2.x; bv[5] = c2.y; bv[6] = c2.z; bv[7] = c2.w; }
        float uf[11][8];
#pragma unroll
        for (int j = 0; j < 11; ++j) unpack8_bf16(ur[j], uf[j]);
#pragma unroll
        for (int r = 0; r < 8; ++r) {
            float cv[8];
#pragma unroll
            for (int e = 0; e < 8; ++e) {
                const float y = wv[0][e] * uf[r][e] + wv[1][e] * uf[r + 1][e] + wv[2][e] * uf[r + 2][e] + wv[3][e] * uf[r + 3][e] + bv[e];
                cv[e] = y * sigmoidf_(y);
            }
            uint4 o; o.x = pk_bf16(cv[0], cv[1]); o.y = pk_bf16(cv[2], cv[3]); o.z = pk_bf16(cv[4], cv[5]); o.w = pk_bf16(cv[6], cv[7]);
            *(uint4*)(sC + (rg * 8 + r) * 136 + cc * 8) = o;
            *(uint4*)(CH + (t0 + rg * 8 + r) * 512 + col) = o;
        }
    }
    if (wave == 0) {
        const float* G = (const float*)(p.ws + OFF_GATES);
        const int l0 = 2 * lane, l1 = l0 + 1;
        const float gi0 = G[(t0 + l0) * 8 + h], gi1 = G[(t0 + l1) * 8 + h];
        const float gf0 = G[(t0 + l0) * 8 + 4 + h], gf1 = G[(t0 + l1) * 8 + 4 + h];
        const float s = gf0 + gf1;
        float incl = s;
#pragma unroll
        for (int o = 1; o < 64; o <<= 1) { const float t = __shfl_up(incl, o); if (lane >= o) incl += t; }
        const float excl = incl - s;
        const float b0 = excl + gf0, b1 = incl;
        const float blast = __shfl(incl, 63);
        const float g0 = blast - b0 + gi0, g1 = blast - b1 + gi1;
        const float m = wave_max(fmaxf(g0, g1));
        sW[l0] = __expf(g0 - m); sW[l1] = __expf(g1 - m);
        float* BC = (float*)(p.ws + OFF_BCUM);
        BC[(t0 + l0) * 4 + h] = b0; BC[(t0 + l1) * 4 + h] = b1;
        if (lane == 0) { ((float*)(p.ws + OFF_MLOC))[item] = m; ((float*)(p.ws + OFF_BLAST))[item] = blast; }
    }
    __syncthreads();
    {
        bf16x8 wq[2][4], wk[2][4];
        const u16* Wq = (const u16*)(p.ws + OFF_WQM) + h * 16384;
        const u16* Wk = (const u16*)(p.ws + OFF_WKM) + h * 16384;
#pragma unroll
        for (int nn = 0; nn < 2; ++nn)
#pragma unroll
            for (int ks = 0; ks < 4; ++ks) {
                wq[nn][ks] = *(const bf16x8*)(Wq + ((wave * 2 + nn) * 16 + fr) * 128 + ks * 32 + fq * 8);
                wk[nn][ks] = *(const bf16x8*)(Wk + ((wave * 2 + nn) * 16 + fr) * 128 + ks * 32 + fq * 8);
            }
        u16* dq = (u16*)(p.ws + OFF_QM);
        u16* dk = (u16*)(p.ws + OFF_KM);
#pragma unroll
        for (int mi = 0; mi < 8; ++mi) {
            bf16x8 af[4];
#pragma unroll
            for (int ks = 0; ks < 4; ++ks) af[ks] = *(const bf16x8*)(sC + (mi * 16 + fr) * 136 + ks * 32 + fq * 8);
            const int row = mi * 16 + fr;
            const float wrow = sW[row];
#pragma unroll
            for (int nn = 0; nn < 2; ++nn) {
                f32x4 aq = (f32x4){0.f, 0.f, 0.f, 0.f}, ak = (f32x4){0.f, 0.f, 0.f, 0.f};
#pragma unroll
                for (int ks = 0; ks < 4; ++ks) { aq = mfma_bf16(wq[nn][ks], af[ks], aq); ak = mfma_bf16(wk[nn][ks], af[ks], ak); }
                const int d = (wave * 2 + nn) * 16 + 4 * fq;
                uint2 w; w.x = pk_bf16(aq[0], aq[1]); w.y = pk_bf16(aq[2], aq[3]);
                *(uint2*)(dq + (t0 + row) * 512 + h * 128 + d) = w;
                w.x = pk_bf16(ak[0], ak[1]); w.y = pk_bf16(ak[2], ak[3]);
                *(uint2*)(dk + (t0 + row) * 512 + h * 128 + d) = w;
                uint2 wkk; wkk.x = pk_bf16(ak[0] * wrow, ak[1] * wrow); wkk.y = pk_bf16(ak[2] * wrow, ak[3] * wrow);
                *(uint2*)(sKT + row * 136 + d) = wkk;
            }
        }
    }
    __syncthreads();
    u16* sVT = sC;
    {
        const u16* VM = (const u16*)(p.ws + OFF_VM);
#pragma unroll
        for (int i = 0; i < 8; ++i) {
            const int c = tid + 256 * i, row = c >> 4, cc = c & 15;
            const uint4 v = *(const uint4*)(VM + (t0 + row) * 512 + h * 128 + cc * 8);
            *(uint4*)(sVT + row * 136 + cc * 8) = v;
        }
    }
    __syncthreads();
    if (tid < 128) {
        float s = 0.f;
#pragma unroll 16
        for (int l = 0; l < 128; ++l) s += bf2f(sKT[l * 136 + tid]);
        ((float*)(p.ws + OFF_NCH))[(size_t)item * 128 + tid] = s;
    }
    {
        f32x4 acc[2][8];
#pragma unroll
        for (int mi = 0; mi < 2; ++mi)
#pragma unroll
            for (int nj = 0; nj < 8; ++nj) acc[mi][nj] = (f32x4){0.f, 0.f, 0.f, 0.f};
#pragma unroll
        for (int ks = 0; ks < 4; ++ks) {
            const int lr = ks * 32 + fq * 8 + (fr >> 2), cs = 4 * (fr & 3);
            const bf16x8 x0 = cat4(ld_tr(sKT + lr * 136 + wave * 32 + cs), ld_tr(sKT + (lr + 4) * 136 + wave * 32 + cs));
            const bf16x8 x1 = cat4(ld_tr(sKT + lr * 136 + wave * 32 + 16 + cs), ld_tr(sKT + (lr + 4) * 136 + wave * 32 + 16 + cs));
#pragma unroll
            for (int nj = 0; nj < 8; ++nj) {
                const bf16x8 y = cat4(ld_tr(sVT + lr * 136 + nj * 16 + cs), ld_tr(sVT + (lr + 4) * 136 + nj * 16 + cs));
                acc[0][nj] = mfma_bf16(x0, y, acc[0][nj]);
                acc[1][nj] = mfma_bf16(x1, y, acc[1][nj]);
            }
        }
        float* CCH = (float*)(p.ws + OFF_CCH) + (size_t)item * 16384;
#pragma unroll
        for (int mi = 0; mi < 2; ++mi)
#pragma unroll
            for (int nj = 0; nj < 8; ++nj) {
                const int kd0 = wave * 32 + mi * 16 + 4 * fq, v = nj * 16 + fr;
                const f32x4 c = acc[mi][nj];
                *(float4*)(CCH + v * 128 + kd0) = make_float4(c[0], c[1], c[2], c[3]);
            }
    }
    __syncthreads();
}

struct AttnItem { int pat, b, h, dl, r, n; };
__device__ __forceinline__ AttnItem attn_decode(const int item) {
    AttnItem a; const int blk = item & 63; a.h = (item >> 6) & 7; a.b = (item >> 9) & 3; a.pat = item >> 11;
    a.dl = 2 * a.pat; const int nb = 64 >> a.dl; a.r = blk >> (6 - a.dl); a.n = blk & (nb - 1); return a;
}
#define ATT_BUF 74368
#define KV_FOR(X) X(0) X(1) X(2) X(3)
#define KV_DECL(i) uint4 kr##i, vr##i;
#define KV_ISSUE(i) { const int c_ = tid + 512 * (i), j_ = c_ >> 3; const int jj_ = (L.n > 0 || j_ >= 128) ? j_ : j_ + 128; \
        const size_t off_ = ((size_t)L.b * SEQ + (size_t)((((L.n - 1) * 128 + jj_) << L.dl) + L.r)) * 512 + L.h * 64 + (c_ & 7) * 8; \
        kr##i = *(const uint4*)(KA + off_); vr##i = *(const uint4*)(VA + off_); }
#define KV_FILL(i) { const int c_ = tid + 512 * (i), j_ = c_ >> 3, cc_ = c_ & 7; const bool valid_ = (F.n > 0) || (j_ >= 128); \
        const uint4 kv_ = valid_ ? kr##i : make_uint4(0, 0, 0, 0), vv_ = valid_ ? vr##i : make_uint4(0, 0, 0, 0); \
        float f_[8]; unpack8_bf16(kv_, f_); float ss_ = 0.f; \
        _Pragma("unroll") for (int e_ = 0; e_ < 8; ++e_) ss_ += f_[e_] * f_[e_]; \
        ss_ += __shfl_xor(ss_, 1); ss_ += __shfl_xor(ss_, 2); ss_ += __shfl_xor(ss_, 4); \
        const float rs_ = rsqrtf(ss_ * (1.0f / 64.0f) + 1e-6f); \
        const float4 g0_ = *(const float4*)(p.kn_g + F.h * 64 + cc_ * 8), g1_ = *(const float4*)(p.kn_g + F.h * 64 + cc_ * 8 + 4); \
        uint4 o_; o_.x = pk_bf16(f_[0] * rs_ * g0_.x, f_[1] * rs_ * g0_.y); o_.y = pk_bf16(f_[2] * rs_ * g0_.z, f_[3] * rs_ * g0_.w); \
        o_.z = pk_bf16(f_[4] * rs_ * g1_.x, f_[5] * rs_ * g1_.y); o_.w = pk_bf16(f_[6] * rs_ * g1_.z, f_[7] * rs_ * g1_.w); \
        *(uint4*)(fK + j_ * 72 + cc_ * 8) = o_; \
        *(uint4*)(fV + j_ * 72 + cc_ * 8) = vv_; }
#define Q_ISSUE(A, B) { const int i_ = wave * 16 + fr; const u16* qrow_ = QA + ((size_t)L.b * SEQ + (size_t)((((L.n * 128) + i_) << L.dl) + L.r)) * 512 + L.h * 64; \
        A = *(const uint4*)(qrow_ + fq * 8); B = *(const uint4*)(qrow_ + 32 + fq * 8); }
#define ATT_FILLBUF(bufp, ITEM) { const AttnItem F = (ITEM); u16* fK = (u16*)(bufp); u16* fV = fK + 256 * 72; float* fB = (float*)(fV + 256 * 72); \
        if (tid < 160) fB[tid] = (tid >= 16 && tid <= 144) ? p.rel_bias[(int)c_bucket[F.pat][tid - 16] * 8 + F.h] : -INFINITY; \
        KV_FOR(KV_FILL) }

__device__ void attn_phase(const Params& p, unsigned char* smem_all) {
    int tid_ = threadIdx.x; asm volatile("" : "+v"(tid_)); const int tid = tid_, lane = tid & 63, wave = __builtin_amdgcn_readfirstlane(tid >> 6), fr = lane & 15, fq = lane >> 4;
    const int G = gridDim.x;
    int item = blockIdx.x;
    if (item >= 6144) return;
    const u16* QA = (const u16*)(p.ws + OFF_QA);
    const u16* KA = (const u16*)(p.ws + OFF_KA);
    const u16* VA = (const u16*)(p.ws + OFF_VA);
    KV_FOR(KV_DECL)
    uint4 q0, q1, nq0, nq1;
    AttnItem C = attn_decode(item);
    { const AttnItem L = C; KV_FOR(KV_ISSUE) Q_ISSUE(q0, q1) }
    ATT_FILLBUF(smem_all, C)
    int par = 0;
    AttnItem N = attn_decode((item + G < 6144) ? item + G : item);
    { const AttnItem L = N; KV_FOR(KV_ISSUE) Q_ISSUE(nq0, nq1) }
    __syncthreads();
    for (;;) {
        const int itn = item + G;
        const bool has_next = itn < 6144;
        AttnItem N2 = N;
        if (has_next) {
            ATT_FILLBUF(smem_all + (par ^ 1) * ATT_BUF, N)
            N2 = attn_decode((itn + G < 6144) ? itn + G : itn);
        }
        uint4 nn0, nn1;
        { const AttnItem L = N2; KV_FOR(KV_ISSUE) Q_ISSUE(nn0, nn1) }
        const u16* sK = (const u16*)(smem_all + par * ATT_BUF);
        const u16* sVT = sK + 256 * 72;
        const float* sBias = (const float*)(sVT + 256 * 72);
        const int n = C.n, h = C.h, dl = C.dl, r = C.r;
        const size_t tb = (size_t)C.b * SEQ;
        const float* sBl = sBias + (16 + 128 - 131 + fr - 4 * fq);
        u16* ATTO = (u16*)(p.ws + OFF_ATTO) + (size_t)C.pat * T_TOK * 512;
        float* LSE = (float*)(p.ws + OFF_LSE) + (size_t)C.pat * T_TOK * 8;
        {
            const int qb = wave;
            const int i = qb * 16 + fr;
            const size_t posq = tb + (size_t)((((n * 128) + i) << dl) + r);
            bf16x8 qf[2];
            {
                float f0[8], f1[8];
                unpack8_bf16(q0, f0); unpack8_bf16(q1, f1);
                float ss = 0.f;
#pragma unroll
                for (int e = 0; e < 8; ++e) ss += f0[e] * f0[e] + f1[e] * f1[e];
                ss += __shfl_xor(ss, 16); ss += __shfl_xor(ss, 32);
                const float rs = rsqrtf(ss * (1.0f / 64.0f) + 1e-6f) * 0.125f;
                const float* g = p.qn_g + h * 64 + fq * 8;
                uint4 o0, o1;
                o0.x = pk_bf16(f0[0] * rs * g[0], f0[1] * rs * g[1]); o0.y = pk_bf16(f0[2] * rs * g[2], f0[3] * rs * g[3]);
                o0.z = pk_bf16(f0[4] * rs * g[4], f0[5] * rs * g[5]); o0.w = pk_bf16(f0[6] * rs * g[6], f0[7] * rs * g[7]);
                o1.x = pk_bf16(f1[0] * rs * g[32], f1[1] * rs * g[33]); o1.y = pk_bf16(f1[2] * rs * g[34], f1[3] * rs * g[35]);
                o1.z = pk_bf16(f1[4] * rs * g[36], f1[5] * rs * g[37]); o1.w = pk_bf16(f1[6] * rs * g[38], f1[7] * rs * g[39]);
                qf[0] = __builtin_bit_cast(bf16x8, o0); qf[1] = __builtin_bit_cast(bf16x8, o1);
            }
            f32x4 s[10];
#pragma unroll
            for (int kk = 0; kk < 9; ++kk) {
                const int kb = qb + kk;
                f32x4 acc = (f32x4){0.f, 0.f, 0.f, 0.f};
#pragma unroll
                for (int ks = 0; ks < 2; ++ks) {
                    const bf16x8 kf = *(const bf16x8*)(sK + (kb * 16 + fr) * 72 + ks * 32 + fq * 8);
                    acc = mfma_bf16(kf, qf[ks], acc);
                }
                s[kk] = acc;
            }
            s[9] = (f32x4){0.f, 0.f, 0.f, 0.f};
            const float mx = 0.f;
            float sum = 0.f;
            if (n > 0) {
#pragma unroll
                for (int kk = 0; kk < 9; ++kk)
#pragma unroll
                    for (int rr = 0; rr < 4; ++rr) {
                        const float e = __expf(s[kk][rr] + sBl[131 - 16 * kk - rr]);
                        s[kk][rr] = e; sum += e;
                    }
            } else {
#pragma unroll
                for (int kk = 0; kk < 9; ++kk)
#pragma unroll
                    for (int rr = 0; rr < 4; ++rr) {
                        const int j = (qb + kk) * 16 + 4 * fq + rr;
                        const float e = (j >= 128) ? __expf(s[kk][rr] + sBl[131 - 16 * kk - rr]) : 0.f;
                        s[kk][rr] = e; sum += e;
                    }
            }
            sum += __shfl_xor(sum, 16); sum += __shfl_xor(sum, 32);
            bf16x8 pf[5];
#pragma unroll
            for (int kp = 0; kp < 5; ++kp) {
                uint4 o;
                o.x = pk_bf16(s[2 * kp][0], s[2 * kp][1]); o.y = pk_bf16(s[2 * kp][2], s[2 * kp][3]);
                o.z = pk_bf16(s[2 * kp + 1][0], s[2 * kp + 1][1]); o.w = pk_bf16(s[2 * kp + 1][2], s[2 * kp + 1][3]);
                pf[kp] = __builtin_bit_cast(bf16x8, o);
            }
            const float inv = 1.0f / sum;
#pragma unroll
            for (int vb = 0; vb < 4; ++vb) {
                f32x4 acc = (f32x4){0.f, 0.f, 0.f, 0.f};
#pragma unroll
                for (int kp = 0; kp < 5; ++kp) {
                    const int kbA = qb + 2 * kp;
                    const int kbB = (kbA + 1 > 15) ? kbA : kbA + 1;
                    const s16x4 lo = ld_tr(sVT + (kbA * 16 + 4 * fq + (fr >> 2)) * 72 + vb * 16 + 4 * (fr & 3));
                    const s16x4 hi = ld_tr(sVT + (kbB * 16 + 4 * fq + (fr >> 2)) * 72 + vb * 16 + 4 * (fr & 3));
                    acc = mfma_bf16(cat4(lo, hi), pf[kp], acc);
                }
                uint2 w; w.x = pk_bf16(acc[0] * inv, acc[1] * inv); w.y = pk_bf16(acc[2] * inv, acc[3] * inv);
                *(uint2*)(ATTO + posq * 512 + h * 64 + vb * 16 + 4 * fq) = w;
            }
            if (fq == 0) LSE[posq * 8 + h] = mx + __logf(sum);
        }
        __syncthreads();
        if (!has_next) break;
        item = itn; C = N; N = N2; q0 = nq0; q1 = nq1; nq0 = nn0; nq1 = nn1; par ^= 1;
    }
}

#define P3_ITEMS 528
__device__ void scan_item(const Params& p, const int item) {
    const int tid = TIDX;
    const float* BL = (const float*)(p.ws + OFF_BLAST);
    const float* ML = (const float*)(p.ws + OFF_MLOC);
    if (item < 512) {
        const int bh = item >> 5;
        const size_t e0 = (size_t)(item & 31) * 512 + tid * 2;
        const float* CCH = (const float*)(p.ws + OFF_CCH);
        u16* CP = (u16*)(p.ws + OFF_CPREV);
        float c0 = 0.f, c1 = 0.f, m = 0.f;
#pragma unroll 1
        for (int nh = 0; nh < 64; nh += 16) {
        float2 ccv[16];
#pragma unroll
        for (int n = 0; n < 16; ++n) ccv[n] = *(const float2*)(CCH + (size_t)(bh * 64 + nh + n) * 16384 + e0);
#pragma unroll
        for (int nn = 0; nn < 16; ++nn) {
            const int n = nh + nn;
            const int it = bh * 64 + n;
            const float bl = BL[it], ml = ML[it];
            const float2 cc = ccv[nn];
            *(unsigned*)(CP + (size_t)it * 16384 + e0) = pk_bf16(c0, c1);
            const float mn = fmaxf(bl + m, ml);
            const float a = __expf(bl + m - mn), bb = __expf(ml - mn);
            c0 = a * c0 + bb * cc.x; c1 = a * c1 + bb * cc.y; m = mn;
        }
        }
    } else {
        const int bh = item - 512;
        if (tid < 128) {
            const float* NCH = (const float*)(p.ws + OFF_NCH);
            float* NP = (float*)(p.ws + OFF_NPREV);
            float* MP = (float*)(p.ws + OFF_MPREV);
            float nv = 0.f, m = 0.f;
#pragma unroll 1
            for (int nh = 0; nh < 64; nh += 16) {
            float ccv[16], blv[16], mlv[16];
#pragma unroll
            for (int n = 0; n < 16; ++n) { ccv[n] = NCH[(size_t)(bh * 64 + nh + n) * 128 + tid]; blv[n] = BL[bh * 64 + nh + n]; mlv[n] = ML[bh * 64 + nh + n]; }
#pragma unroll
            for (int nn = 0; nn < 16; ++nn) {
                const int n = nh + nn;
                const int it = bh * 64 + n;
                const float bl = blv[nn], ml = mlv[nn];
                const float cc = ccv[nn];
                NP[(size_t)it * 128 + tid] = nv;
                if (tid == 0) MP[it] = m;
                const float mn = fmaxf(bl + m, ml);
                const float a = __expf(bl + m - mn), bb = __expf(ml - mn);
                nv = a * nv + bb * cc; m = mn;
            }
            }
        }
    }
}

__device__ void mlstm_out(const Params& p, const int item, unsigned char* smem) {
    int tid_ = TIDX; asm volatile("" : "+v"(tid_)); const int tid = tid_, lane = tid & 63, wave = __builtin_amdgcn_readfirstlane(tid >> 6), fr = lane & 15, fq = lane >> 4;
    const int b = item >> 8, h = (item >> 6) & 3, n = item & 63;
    const size_t t0 = (size_t)b * SEQ + (size_t)n * 128;
    u16* sK = (u16*)smem;
    u16* sVT = sK + 128 * 136;
    float* sAj = (float*)(sVT + 128 * 136);
    float* sMi = sAj + 128;
    float* sBi = sMi + 128;
    float* sNp = sBi + 128;
    const u16* KM = (const u16*)(p.ws + OFF_KM);
    const u16* VM = (const u16*)(p.ws + OFF_VM);
    const u16* QM = (const u16*)(p.ws + OFF_QM);
    const u16* CP = (const u16*)(p.ws + OFF_CPREV) + (size_t)item * 16384;
    const float mprev = ((const float*)(p.ws + OFF_MPREV))[item];
    uint4 kr[8], vr[8];
#define CR_FOR(X) X(0) X(1) X(2) X(3) X(4) X(5) X(6) X(7)
#define CR_DECL(i) uint4 cr##i;
#define CR_LOAD(i) { const int c_ = tid + 256 * (i); cr##i = *(const uint4*)(CP + (c_ >> 4) * 128 + (c_ & 15) * 8); }
#define CR_STORE(i) { const int c_ = tid + 256 * (i); *(uint4*)(sK + (c_ >> 4) * 136 + (c_ & 15) * 8) = cr##i; }
    CR_FOR(CR_DECL)
#pragma unroll
    for (int i = 0; i < 8; ++i) {
        const int c = tid + 256 * i, row = c >> 4, cc = c & 15;
        kr[i] = *(const uint4*)(KM + (t0 + row) * 512 + h * 128 + cc * 8);
        vr[i] = *(const uint4*)(VM + (t0 + row) * 512 + h * 128 + cc * 8);
    }
    CR_FOR(CR_LOAD)
    bf16x8 qf[2][4];
#pragma unroll
    for (int qbl = 0; qbl < 2; ++qbl) {
        const u16* qrow = QM + (t0 + (wave * 2 + qbl) * 16 + fr) * 512 + h * 128;
#pragma unroll
        for (int ks = 0; ks < 4; ++ks) qf[qbl][ks] = *(const bf16x8*)(qrow + ks * 32 + fq * 8);
    }
#pragma unroll
    for (int i = 0; i < 8; ++i) {
        const int c = tid + 256 * i, row = c >> 4, cc = c & 15;
        *(uint4*)(sK + row * 136 + cc * 8) = kr[i];
        *(uint4*)(sVT + row * 136 + cc * 8) = vr[i];
    }
    if (wave == 0) {
        const float* G = (const float*)(p.ws + OFF_GATES);
        const float* BC = (const float*)(p.ws + OFF_BCUM);
        const int l0 = 2 * lane, l1 = l0 + 1;
        const float b0 = BC[(t0 + l0) * 4 + h], b1 = BC[(t0 + l1) * 4 + h];
        const float a0 = G[(t0 + l0) * 8 + h] - b0, a1 = G[(t0 + l1) * 8 + h] - b1;
        const float pm = fmaxf(a0, a1);
        float incl = pm;
#pragma unroll
        for (int o = 1; o < 64; o <<= 1) { const float t = __shfl_up(incl, o); if (lane >= o) incl = fmaxf(incl, t); }
        float excl = __shfl_up(incl, 1);
        if (lane == 0) excl = -INFINITY;
        sAj[l0] = a0; sAj[l1] = a1;
        sMi[l0] = fmaxf(mprev, fmaxf(excl, a0)); sMi[l1] = fmaxf(mprev, incl);
        sBi[l0] = b0; sBi[l1] = b1;
    } else if (wave == 1) {
        const float* NP = (const float*)(p.ws + OFF_NPREV) + (size_t)item * 128;
        sNp[lane] = NP[lane]; sNp[lane + 64] = NP[lane + 64];
    }
    __syncthreads();
    f32x4 acc[2][8];
    float rowsum[2], qn[2], Mq[2];
#pragma unroll
    for (int qbl = 0; qbl < 2; ++qbl) {
        const int qb = wave * 2 + qbl;
        const int i = qb * 16 + fr;
        const float Mi = sMi[i];
        Mq[qbl] = Mi;
        float qnv = 0.f;
#pragma unroll
        for (int ks = 0; ks < 4; ++ks)
#pragma unroll
            for (int e = 0; e < 8; ++e) qnv += bf2f((u16)qf[qbl][ks][e]) * sNp[ks * 32 + fq * 8 + e];
        qnv += __shfl_xor(qnv, 16); qnv += __shfl_xor(qnv, 32);
        qn[qbl] = qnv;
#pragma unroll
        for (int vb = 0; vb < 8; ++vb) acc[qbl][vb] = (f32x4){0.f, 0.f, 0.f, 0.f};
        float rs_ = 0.f;
#pragma unroll
        for (int kp = 0; kp < 4; ++kp) {
            if (2 * kp <= qb) {
                f32x4 s0 = (f32x4){0.f, 0.f, 0.f, 0.f}, s1 = (f32x4){0.f, 0.f, 0.f, 0.f};
#pragma unroll
                for (int ks = 0; ks < 4; ++ks) {
                    const bf16x8 kf = *(const bf16x8*)(sK + ((2 * kp) * 16 + fr) * 136 + ks * 32 + fq * 8);
                    s0 = mfma_bf16(kf, qf[qbl][ks], s0);
                }
                if (2 * kp + 1 <= qb) {
#pragma unroll
                    for (int ks = 0; ks < 4; ++ks) {
                        const bf16x8 kf = *(const bf16x8*)(sK + ((2 * kp + 1) * 16 + fr) * 136 + ks * 32 + fq * 8);
                        s1 = mfma_bf16(kf, qf[qbl][ks], s1);
                    }
                }
#pragma unroll
                for (int rr = 0; rr < 4; ++rr) {
                    const int j0 = (2 * kp) * 16 + 4 * fq + rr, j1 = j0 + 16;
                    const float d0 = (j0 <= i) ? __expf(sAj[j0] - Mi) : 0.f;
                    const float d1 = (j1 <= i) ? __expf(sAj[j1] - Mi) : 0.f;
                    s0[rr] *= d0; s1[rr] *= d1;
                    rs_ += s0[rr] + s1[rr];
                }
                uint4 o;
                o.x = pk_bf16(s0[0], s0[1]); o.y = pk_bf16(s0[2], s0[3]);
                o.z = pk_bf16(s1[0], s1[1]); o.w = pk_bf16(s1[2], s1[3]);
                const bf16x8 pf = __builtin_bit_cast(bf16x8, o);
#pragma unroll
                for (int vb = 0; vb < 8; ++vb) {
                    const s16x4 lo = ld_tr(sVT + ((2 * kp) * 16 + 4 * fq + (fr >> 2)) * 136 + vb * 16 + 4 * (fr & 3));
                    const s16x4 hi = ld_tr(sVT + ((2 * kp + 1) * 16 + 4 * fq + (fr >> 2)) * 136 + vb * 16 + 4 * (fr & 3));
                    acc[qbl][vb] = mfma_bf16(cat4(lo, hi), pf, acc[qbl][vb]);
                }
            }
            asm volatile("" ::: "memory");
        }
        rs_ += __shfl_xor(rs_, 16); rs_ += __shfl_xor(rs_, 32);
        rowsum[qbl] = rs_;
    }
    __syncthreads();
    CR_FOR(CR_STORE)
    __syncthreads();
    const u16* CH = (const u16*)(p.ws + OFF_CH);
    const u16* Z = (const u16*)(p.ws + OFF_Z);
    u16* Y = (u16*)(p.ws + OFF_Y);
#pragma unroll
    for (int qbl = 0; qbl < 2; ++qbl) {
        const int qb = wave * 2 + qbl;
        const int i = qb * 16 + fr;
        uint2 chv[8], zv[8];
#pragma unroll
        for (int vb = 0; vb < 8; ++vb) {
            const int v = h * 128 + vb * 16 + 4 * fq;
            chv[vb] = *(const uint2*)(CH + (t0 + i) * 512 + v); zv[vb] = *(const uint2*)(Z + (t0 + i) * 512 + v);
        }
        const float Mi = Mq[qbl];
        const float iw = __expf(mprev - Mi);
#pragma unroll
        for (int vb = 0; vb < 8; ++vb) {
            f32x4 a = (f32x4){0.f, 0.f, 0.f, 0.f};
#pragma unroll
            for (int ks = 0; ks < 4; ++ks) {
                const bf16x8 cf = *(const bf16x8*)(sK + (vb * 16 + fr) * 136 + ks * 32 + fq * 8);
                a = mfma_bf16(cf, qf[qbl][ks], a);
            }
            acc[qbl][vb] = acc[qbl][vb] + a * iw;
        }
        const float den = rowsum[qbl] + iw * qn[qbl];
        const float mt = sBi[i] + Mi;
        const float inv = 1.0f / fmaxf(fabsf(den), __expf(-mt));
        float ss = 0.f;
#pragma unroll
        for (int vb = 0; vb < 8; ++vb) { acc[qbl][vb] = acc[qbl][vb] * inv; ss += acc[qbl][vb][0] * acc[qbl][vb][0] + acc[qbl][vb][1] * acc[qbl][vb][1] + acc[qbl][vb][2] * acc[qbl][vb][2] + acc[qbl][vb][3] * acc[qbl][vb][3]; }
        ss += __shfl_xor(ss, 16); ss += __shfl_xor(ss, 32);
        const float rs = rsqrtf(ss * (1.0f / 128.0f) + 1e-6f);
#pragma unroll
        for (int vb = 0; vb < 8; ++vb) {
            const int v = h * 128 + vb * 16 + 4 * fq;
            const float4 g = *(const float4*)(p.mh_norm_g + v), sk = *(const float4*)(p.skip_m + v);
            const float c0 = __uint_as_float(chv[vb].x << 16), c1 = __uint_as_float(chv[vb].x & 0xffff0000u), c2 = __uint_as_float(chv[vb].y << 16), c3 = __uint_as_float(chv[vb].y & 0xffff0000u);
            const float z0 = __uint_as_float(zv[vb].x << 16), z1 = __uint_as_float(zv[vb].x & 0xffff0000u), z2 = __uint_as_float(zv[vb].y << 16), z3 = __uint_as_float(zv[vb].y & 0xffff0000u);
            const float y0 = sigmoidf_(z0) * (acc[qbl][vb][0] * rs * g.x + sk.x * c0);
            const float y1 = sigmoidf_(z1) * (acc[qbl][vb][1] * rs * g.y + sk.y * c1);
            const float y2 = sigmoidf_(z2) * (acc[qbl][vb][2] * rs * g.z + sk.z * c2);
            const float y3 = sigmoidf_(z3) * (acc[qbl][vb][3] * rs * g.w + sk.w * c3);
            uint2 w; w.x = pk_bf16(y0, y1); w.y = pk_bf16(y2, y3);
            *(uint2*)(Y + (t0 + i) * 1024 + v) = w;
        }
        asm volatile("" ::: "memory");
    }
    __syncthreads();
}

__device__ void attn_combine4(const Params& p, const int item0, const int istride) {
    const float* LSE = (const float*)(p.ws + OFF_LSE);
    const u16* AO = (const u16*)(p.ws + OFF_ATTO);
    uint4 a0[4], a1[4], a2[4]; float l0[4], l1[4], l2[4]; size_t tt[4]; int hh[4], cc[4];
#pragma unroll
    for (int q = 0; q < 4; ++q) {
        const size_t idx = (size_t)(item0 + q * istride) * 256 + TIDX;
        const size_t t = idx >> 6; const int h = (int)(idx >> 3) & 7, c8 = (int)idx & 7;
        tt[q] = t; hh[q] = h; cc[q] = c8;
        l0[q] = LSE[t * 8 + h]; l1[q] = LSE[(size_t)T_TOK * 8 + t * 8 + h]; l2[q] = LSE[(size_t)2 * T_TOK * 8 + t * 8 + h];
        const size_t off = t * 512 + h * 64 + c8 * 8;
        a0[q] = *(const uint4*)(AO + off); a1[q] = *(const uint4*)(AO + (size_t)T_TOK * 512 + off); a2[q] = *(const uint4*)(AO + (size_t)2 * T_TOK * 512 + off);
    }
#pragma unroll
    for (int q = 0; q < 4; ++q) {
        const float mx = fmaxf(l0[q], fmaxf(l1[q], l2[q]));
        const float e0 = __expf(l0[q] - mx), e1 = __expf(l1[q] - mx), e2 = __expf(l2[q] - mx);
        const float inv = __builtin_amdgcn_rcpf(e0 + e1 + e2);
        float f0[8], f1[8], f2[8];
        unpack8_bf16(a0[q], f0); unpack8_bf16(a1[q], f1); unpack8_bf16(a2[q], f2);
        float o[8];
#pragma unroll
        for (int e = 0; e < 8; ++e) o[e] = (e0 * f0[e] + e1 * f1[e] + e2 * f2[e]) * inv;
        uint4 w; w.x = pk_bf16(o[0], o[1]); w.y = pk_bf16(o[2], o[3]); w.z = pk_bf16(o[4], o[5]); w.w = pk_bf16(o[6], o[7]);
        *(uint4*)((u16*)(p.ws + OFF_Y) + tt[q] * 1024 + 512 + hh[q] * 64 + cc[q] * 8) = w;
    }
}

#define P6_ROWITEMS (T_TOK / 16)
#define P6_ITEMS (P6_ROWITEMS + 4096)
__device__ void phase6_item(const Params& p, const int item) {
    int tid_ = TIDX; asm volatile("" : "+v"(tid_)); const int tid = tid_, lane = tid & 63, wave = __builtin_amdgcn_readfirstlane(tid >> 6);
    if (item < P6_ROWITEMS) {
        const int row0 = item * 16 + wave * 4;
        float4 v[4][4];
        float ss[4] = {0.f, 0.f, 0.f, 0.f};
#pragma unroll
        for (int rr = 0; rr < 4; ++rr) {
            const float4* xr = (const float4*)((const float*)(p.ws + OFF_X1) + (size_t)(row0 + rr) * DM);
#pragma unroll
            for (int j = 0; j < 4; ++j) v[rr][j] = xr[lane + 64 * j];
        }
#pragma unroll
        for (int rr = 0; rr < 4; ++rr) {
#pragma unroll
            for (int j = 0; j < 4; ++j) ss[rr] += v[rr][j].x * v[rr][j].x + v[rr][j].y * v[rr][j].y + v[rr][j].z * v[rr][j].z + v[rr][j].w * v[rr][j].w;
            ss[rr] = wave_sum(ss[rr]);
        }
#pragma unroll
        for (int rr = 0; rr < 4; ++rr) {
            const int row = row0 + rr;
            const float rs = rsqrtf(ss[rr] * (1.0f / 1024.0f) + 1e-6f);
            u16* h2 = (u16*)(p.ws + OFF_H2) + (size_t)row * DM;
#pragma unroll
            for (int j = 0; j < 4; ++j) {
                const float4 g = ((const float4*)p.norm2_g)[lane + 64 * j];
                const float y0 = v[rr][j].x * rs * g.x, y1 = v[rr][j].y * rs * g.y, y2 = v[rr][j].z * rs * g.z, y3 = v[rr][j].w * rs * g.w;
                uint2 w; w.x = pk_bf16(y0, y1); w.y = pk_bf16(y2, y3);
                *(uint2*)(h2 + 4 * (lane + 64 * j)) = w;
                *(unsigned*)(p.ws + OFF_H2Q + (size_t)row * DM + 4 * (lane + 64 * j)) = pk4_fp8(y0 * 16.f, y1 * 16.f, y2 * 16.f, y3 * 16.f);
            }
        }
    } else {
        const int it = item - P6_ROWITEMS;
        const int which = it >> 10;
        const size_t base = (size_t)(it & 1023) * 16384;
        const float* src = (which ? p.expert_v : p.expert_u) + base;
        unsigned char* dst = p.ws + (which ? OFF_EV8 : OFF_EU8);
        float4 v[16];
#pragma unroll
        for (int i = 0; i < 16; ++i) v[i] = *(const float4*)(src + (tid + 256 * i) * 4);
#pragma unroll
        for (int i = 0; i < 16; ++i) {
            const size_t gi = base + (size_t)(tid + 256 * i) * 4, row = gi >> 10, d = gi & 1023;
            *(unsigned*)(dst + row * 1024 + ((((d >> 7) + row) & 7) << 7) + (d & 127)) = pk4_fp8(v[i].x * 256.f, v[i].y * 256.f, v[i].z * 256.f, v[i].w * 256.f);
        }
    }
}

#define INSERT16(top, x)                                                    \
    do {                                                                    \
        if ((x) > top[15]) {                                                \
            _Pragma("unroll") for (int _i = 15; _i >= 1; --_i) top[_i] = __builtin_amdgcn_fmed3f(top[_i - 1], (x), top[_i]); \
            top[0] = fmaxf(top[0], (x));                                    \
        }                                                                   \
    } while (0)

#define CE_DESC(a, b) do { const float _hi = fmaxf(a, b), _lo = fminf(a, b); a = _hi; b = _lo; } while (0)
#define BITONIC_SORT16_DESC(v)                                                                                   \
    do {                                                                                                         \
        _Pragma("unroll") for (int _k = 2; _k <= 16; _k <<= 1)                                                   \
            _Pragma("unroll") for (int _j = _k >> 1; _j > 0; _j >>= 1)                                           \
                _Pragma("unroll") for (int _i = 0; _i < 16; ++_i) {                                              \
                    const int _l = _i ^ _j;                                                                      \
                    if (_l > _i) { if ((_i & _k) == 0) CE_DESC(v[_i], v[_l]); else CE_DESC(v[_l], v[_i]); }      \
                }                                                                                                \
    } while (0)
#define MERGE16_XOR(top, XOR)                                                                                   \
    do {                                                                                                        \
        _Pragma("unroll") for (int _i = 0; _i < 8; ++_i) {                                                      \
            const float _o0 = __shfl_xor(top[15 - _i], XOR), _o1 = __shfl_xor(top[_i], XOR);                    \
            const float _c0 = fmaxf(top[_i], _o0), _c1 = fmaxf(top[15 - _i], _o1);                              \
            top[_i] = _c0; top[15 - _i] = _c1;                                                                  \
        }                                                                                                       \
        _Pragma("unroll") for (int _s = 8; _s >= 1; _s >>= 1)                                                   \
            _Pragma("unroll") for (int _i = 0; _i < 16; ++_i) if ((_i & _s) == 0) CE_DESC(top[_i], top[_i + _s]); \
    } while (0)

__device__ void peer_score_stage(const Params& p, const int h, unsigned char* smem) {
    const int tid = TIDX;
#pragma unroll
    for (int i = 0; i < 16; ++i) {
        const int c = tid + 256 * i, half = c >> 11, key = (c >> 4) & 127, ch = c & 15;
        const uint4 v = *(const uint4*)((const u16*)(p.ws + (half ? OFF_SK2 : OFF_SK1)) + h * 16384 + key * 128 + ch * 8);
        *(uint4*)(smem + half * 32768 + key * 256 + ((ch ^ (key & 15)) << 4)) = v;
    }
    __syncthreads();
}
__device__ void peer_score(const Params& p, const int item, unsigned char* smem) {
    int tid_ = TIDX; asm volatile("" : "+v"(tid_)); const int tid = tid_, lane = tid & 63, wave = __builtin_amdgcn_readfirstlane(tid >> 6), fr = lane & 15, fq = lane >> 4;
    const int tile = item >> 3, h = item & 7;
    const size_t tok = (size_t)tile * 64 + wave * 16 + fr;
    float* sL = (float*)(smem + 65536) + wave * (16 * 48);
    float vtop[2][16];
#pragma unroll
    for (int half = 0; half < 2; ++half) {
        const unsigned char* SKl = smem + half * 32768;
        const u16* qrow = (const u16*)(p.ws + OFF_QP) + tok * 2048 + h * 256 + half * 128;
        bf16x8 yf[4];
#pragma unroll
        for (int ks = 0; ks < 4; ++ks) yf[ks] = *(const bf16x8*)(qrow + ks * 32 + fq * 8);
        float top[16], sec[16];
#pragma unroll
        for (int kb = 0; kb < 8; ++kb) {
            f32x4 a = (f32x4){0.f, 0.f, 0.f, 0.f};
#pragma unroll
            for (int ks = 0; ks < 4; ++ks) {
                const bf16x8 xf = *(const bf16x8*)(SKl + (kb * 16 + fr) * 256 + (((ks * 4 + fq) ^ fr) << 4));
                a = mfma_f16(xf, yf[ks], a);
            }
#pragma unroll
            for (int rr = 0; rr < 4; ++rr) {
                const float x = __uint_as_float((__float_as_uint(a[rr]) & ~0x7Fu) | (unsigned)(kb * 16 + 4 * fq + rr));
                if (kb < 4) top[kb * 4 + rr] = x; else sec[(kb - 4) * 4 + rr] = x;
            }
        }
        BITONIC_SORT16_DESC(top);
        BITONIC_SORT16_DESC(sec);
#pragma unroll
        for (int i = 0; i < 16; ++i) top[i] = fmaxf(top[i], sec[15 - i]);
#pragma unroll
        for (int st = 8; st >= 1; st >>= 1)
#pragma unroll
            for (int i = 0; i < 16; ++i) if ((i & st) == 0) CE_DESC(top[i], top[i + st]);
        MERGE16_XOR(top, 16);
        MERGE16_XOR(top, 32);
#pragma unroll
        for (int i = 0; i < 16; ++i) vtop[half][i] = top[i];
    }
    float best[16];
#pragma unroll
    for (int i = 0; i < 16; ++i) best[i] = -INFINITY;
    {
        float cx[52];
        int nc = 0;
#pragma unroll
        for (int a = 0; a < 16; ++a)
#pragma unroll
            for (int bb = 0; bb < 16; ++bb)
                if ((a + 1) * (bb + 1) <= 16) {
                    const float sm = vtop[0][a] + vtop[1][bb];
                    cx[nc++] = __uint_as_float((__float_as_uint(sm) & ~0xFFu) | (unsigned)(a * 16 + bb));
                }
        cx[50] = -INFINITY; cx[51] = -INFINITY;
#pragma unroll
        for (int m = 0; m < 13; ++m) {
            const float x = fq == 0 ? cx[4 * m] : fq == 1 ? cx[4 * m + 1] : fq == 2 ? cx[4 * m + 2] : cx[4 * m + 3];
            INSERT16(best, x);
        }
    }
    MERGE16_XOR(best, 16);
    MERGE16_XOR(best, 32);
    float sum = 0.f;
#pragma unroll
    for (int i = 0; i < 16; ++i) sum += __expf(best[i] - best[0]);
    const float inv = 1.0f / sum, b0 = best[0];
    if (fq == 0) {
#pragma unroll
        for (int i = 0; i < 16; ++i) { sL[fr * 48 + i] = vtop[0][i]; sL[fr * 48 + 16 + i] = vtop[1][i]; sL[fr * 48 + 32 + i] = best[i]; }
    }
    int* PI = (int*)(p.ws + OFF_PIDX) + tok * 128 + h * 16 + 4 * fq;
    float* PG = (float*)(p.ws + OFF_PGATE) + tok * 128 + h * 16 + 4 * fq;
    int oi[4]; float og[4];
#pragma unroll
    for (int r = 0; r < 4; ++r) {
        const float bv = sL[fr * 48 + 32 + 4 * fq + r];
        const unsigned ab = __float_as_uint(bv) & 0xFFu;
        const unsigned e1 = __float_as_uint(sL[fr * 48 + (ab >> 4)]) & 0x7Fu;
        const unsigned e2 = __float_as_uint(sL[fr * 48 + 16 + (ab & 15u)]) & 0x7Fu;
        oi[r] = (int)(e1 * 128u + e2);
        og[r] = __expf(bv - b0) * inv;
    }
    *(int4*)PI = make_int4(oi[0], oi[1], oi[2], oi[3]);
    *(float4*)PG = make_float4(og[0], og[1], og[2], og[3]);
}

__device__ void peer_u_phase(const Params& p, unsigned char* smem) {
    int tid_ = TIDX; asm volatile("" : "+v"(tid_)); const int tid = tid_, lane = tid & 63, wave = __builtin_amdgcn_readfirstlane(tid >> 6), fr = lane & 15, fq = lane >> 4;
    const int c = (int)(blockIdx.x & 7), rank = (int)(blockIdx.x >> 3) * 2 + HALFID, nr = (int)(gridDim.x >> 3) * 2;
    const int r8 = lane >> 3, l8 = lane & 7;
    unsigned char* sU = smem + wave * 16384;
    const unsigned char* EU8 = p.ws + OFF_EU8 + 16 * l8;
    u16* PP = (u16*)(p.ws + OFF_PPRE) + (size_t)c * T_TOK * 128;
    for (int t = rank * 4 + wave; t < T_TOK; t += nr * 4) {
        const int* PI = (const int*)(p.ws + OFF_PIDX) + (size_t)t * 128;
        const int idxA = PI[lane], idxB = PI[64 + lane];
        const unsigned char* hq = p.ws + OFF_H2Q + (size_t)t * DM + 128 * c + 16 * fq;
        const uint4 hb0 = *(const uint4*)hq, hb1 = *(const uint4*)(hq + 64);
        const long b0 = (long)(((unsigned long)hb0.y << 32) | hb0.x), b1 = (long)(((unsigned long)hb0.w << 32) | hb0.z);
        const long b2 = (long)(((unsigned long)hb1.y << 32) | hb1.x), b3 = (long)(((unsigned long)hb1.w << 32) | hb1.z);
        uint4 ua[16];
#pragma unroll
        for (int m = 0; m < 16; ++m) {
            const int myidx = __builtin_amdgcn_ds_bpermute(((m & 7) * 8 + r8) << 2, m < 8 ? idxA : idxB);
            ua[m] = *(const uint4*)(EU8 + (size_t)myidx * DM + (((c + myidx) & 7) << 7));
        }
#pragma unroll
        for (int m = 0; m < 16; ++m) *(uint4*)(sU + (8 * m + r8) * 128 + ((l8 ^ r8) << 4)) = ua[m];
#pragma unroll
        for (int eb = 0; eb < 8; ++eb) {
            const unsigned char* row = sU + (16 * eb + fr) * 128;
            const uint4 a0 = *(const uint4*)(row + ((fq ^ (fr & 7)) << 4)), a1 = *(const uint4*)(row + (((4 + fq) ^ (fr & 7)) << 4));
            f32x4 acc = (f32x4){0.f, 0.f, 0.f, 0.f};
            acc = mfma_fp8((long)(((unsigned long)a0.y << 32) | a0.x), b0, acc);
            acc = mfma_fp8((long)(((unsigned long)a0.w << 32) | a0.z), b1, acc);
            acc = mfma_fp8((long)(((unsigned long)a1.y << 32) | a1.x), b2, acc);
            acc = mfma_fp8((long)(((unsigned long)a1.w << 32) | a1.z), b3, acc);
            if (fr == 0) { uint2 w; w.x = pk_f16(acc[0], acc[1]); w.y = pk_f16(acc[2], acc[3]); *(uint2*)(PP + (size_t)t * 128 + 16 * eb + 4 * fq) = w; }
        }
    }
}
__device__ void peer_combine_phase(const Params& p) {
    const u16* PP = (const u16*)(p.ws + OFF_PPRE);
    const float* PG = (const float*)(p.ws + OFF_PGATE);
    float* AW = (float*)(p.ws + OFF_AW);
    for (size_t i = ((size_t)VBID * 256 + TIDX) * 4; i < (size_t)T_TOK * 128; i += (size_t)VGRID * 256 * 4) {
        float4 s = make_float4(0.f, 0.f, 0.f, 0.f);
#pragma unroll
        for (int c = 0; c < 8; ++c) {
            const uint2 w = *(const uint2*)(PP + (size_t)c * T_TOK * 128 + i);
            const f16x2 lo = __builtin_bit_cast(f16x2, w.x), hi = __builtin_bit_cast(f16x2, w.y);
            s.x += (float)lo.x; s.y += (float)lo.y; s.z += (float)hi.x; s.w += (float)hi.y;
        }
        const float4 g = *(const float4*)(PG + i);
        const float pr[4] = {s.x * (1.0f / 4096.0f), s.y * (1.0f / 4096.0f), s.z * (1.0f / 4096.0f), s.w * (1.0f / 4096.0f)};
        const float gg[4] = {g.x, g.y, g.z, g.w};
        float o[4];
#pragma unroll
        for (int r = 0; r < 4; ++r) o[r] = 0.5f * pr[r] * (1.0f + erff(pr[r] * 0.70710678118654752f)) * gg[r] * (1.0f / 256.0f);
        *(float4*)(AW + i) = make_float4(o[0], o[1], o[2], o[3]);
    }
}
__device__ __forceinline__ void axpy16_fp8(const float a, const uint4 v, float* acc) {
    const unsigned w[4] = {v.x, v.y, v.z, v.w};
#pragma unroll
    for (int e = 0; e < 4; ++e) {
        const f32x2 lo = __builtin_amdgcn_cvt_pk_f32_fp8((int)w[e], false), hi = __builtin_amdgcn_cvt_pk_f32_fp8((int)w[e], true);
        acc[4 * e + 0] += a * lo.x; acc[4 * e + 1] += a * lo.y; acc[4 * e + 2] += a * hi.x; acc[4 * e + 3] += a * hi.y;
    }
}
__device__ void peer_v_phase(const Params& p, unsigned char* smem) {
    int tid_ = TIDX; asm volatile("" : "+v"(tid_)); const int tid = tid_, lane = tid & 63, wave = __builtin_amdgcn_readfirstlane(tid >> 6);
    const int c = (int)(blockIdx.x & 7), rank = (int)(blockIdx.x >> 3) * 2 + HALFID, nr = (int)(gridDim.x >> 3) * 2;
    const int g = lane >> 3, l8 = lane & 7;
    uint2* sIA = (uint2*)(smem + wave * 8192);
    const unsigned char* EV8 = p.ws + OFF_EV8 + 16 * l8;
    for (int gi = rank * 4 + wave; gi < T_TOK / 8; gi += nr * 4) {
        const size_t t0 = (size_t)gi * 8;
        const int* PI = (const int*)(p.ws + OFF_PIDX) + t0 * 128;
        const unsigned* AW = (const unsigned*)(p.ws + OFF_AW) + t0 * 128;
#pragma unroll
        for (int i = 0; i < 16; ++i) {
            const int e = lane + 64 * i; const unsigned ix = (unsigned)PI[e];
            sIA[e] = make_uint2(ix * 1024u + (((ix + (unsigned)c) & 7u) << 7), AW[e]);
        }
        float acc[16];
#pragma unroll
        for (int i = 0; i < 16; ++i) acc[i] = 0.f;
#pragma unroll 1
        for (int s0 = 0; s0 < 128; s0 += 16) {
            uint4 vv[16]; float aa[16];
#pragma unroll
            for (int j = 0; j < 16; ++j) {
                const uint2 ia = sIA[g * 128 + s0 + j];
                aa[j] = __uint_as_float(ia.y);
                vv[j] = *(const uint4*)(EV8 + ia.x);
            }
#pragma unroll
            for (int j = 0; j < 16; ++j) axpy16_fp8(aa[j], vv[j], acc);
        }
        float* o = p.out + (t0 + g) * DM + 128 * c + 16 * l8;
        const float* xi = (const float*)(p.ws + OFF_X1) + (t0 + g) * DM + 128 * c + 16 * l8;
#pragma unroll
        for (int i = 0; i < 4; ++i) {
            float4 x = *(const float4*)(xi + 4 * i);
            x.x += acc[4 * i]; x.y += acc[4 * i + 1]; x.z += acc[4 * i + 2]; x.w += acc[4 * i + 3];
            *(float4*)(o + 4 * i) = x;
        }
    }
}

#define N_PHASES 12
__global__ void __launch_bounds__(512, 2) hymba_mega(const Params p, const int ph_lo, const int ph_hi) {
    extern __shared__ __attribute__((aligned(16))) unsigned char smem_all[];
    unsigned char* smem = smem_all + (threadIdx.x >> 8) * SMEM_HALF;
    const int G = VGRID, bid = VBID;
#ifndef PH_ONLY
#define PH_ONLY -1
#endif
#ifndef REP_PH
#define REP_PH -1
#endif
#define PH_RUN(k) ((PH_ONLY < 0 || PH_ONLY == (k)) && ph_lo <= (k) && (k) <= ph_hi)
#define PH_REPS(k) ((REP_PH == (k)) ? 2 : 1)
#define PH_SYNC(k) do { if ((k) < ph_hi && (k) >= ph_lo) { XcdBarrier xb_; xb_.bar = (unsigned*)(p.ws + OFF_BAR); xb_.x = xb_xcc_id(); xb_.st = (volatile unsigned*)&xb_words; xcd_barrier(xb_); } } while (0)
    __shared__ uint4 xb_words;
    if (threadIdx.x == 0) xb_words = make_uint4(0u, 0u, 0u, 0u);
    __syncthreads();
    (void)xcd_barrier_post((unsigned*)(p.ws + OFF_BAR), (volatile unsigned*)&xb_words);
    if (PH_RUN(0)) for (int rep = 0; rep < PH_REPS(0); ++rep) phase0(p, smem);
    PH_SYNC(0);
    if (PH_RUN(1)) for (int rep = 0; rep < PH_REPS(1); ++rep) {
        pg8::Gemm g{(const u16*)(p.ws + OFF_H1), (const u16*)(p.ws + OFF_WT_IN), T_TOK, 3072, 1024}; pg8::StaticOrder S; S.init(T_TOK, 3072, (int)gridDim.x, (int)blockIdx.x);
        pg8::EpiBf16<0> E{(u16*)(p.ws + OFF_R1), 512, nullptr, 512, (size_t)16 * MIB, 1.0f};
        pg8::gemm_phase<pg8::EpiBf16<0>, pg8::StaticOrder, true, true>((PG8_LAS unsigned char*)smem_all, g, S, E);
    }
    PH_SYNC(1);
    if (PH_RUN(2)) for (int rep = 0; rep < PH_REPS(2); ++rep)
        { for (int t = bid; t < 1024; t += G) mlstm_local(p, t, smem); __syncthreads(); attn_phase(p, smem_all); }
    PH_SYNC(2);
    if (PH_RUN(3)) for (int rep = 0; rep < PH_REPS(3); ++rep) {
        for (int t = bid; t < P3_ITEMS; t += G) scan_item(p, t);
        if (bid >= 16) for (int t = bid - 16; t < 2048; t += G - 16) phase6_item(p, P6_ROWITEMS + t);
    }
    PH_SYNC(3);
    if (PH_RUN(4)) for (int rep = 0; rep < PH_REPS(4); ++rep)
        { for (int t = bid; t < 1024; t += G) mlstm_out(p, t, smem); for (int t = bid; t < 8192; t += 4 * G) attn_combine4(p, t, G); }
    PH_SYNC(4);
    if (PH_RUN(5)) for (int rep = 0; rep < PH_REPS(5); ++rep) {
        pg8::Gemm g{(const u16*)(p.ws + OFF_Y), (const u16*)(p.ws + OFF_WT_OUT), T_TOK, 1024, 1024}; pg8::StaticOrder S; S.init(T_TOK, 1024, (int)gridDim.x, (int)blockIdx.x);
        pg8::EpiResF32 E{p.x, (float*)(p.ws + OFF_X1), 1024};
        pg8::gemm_phase<pg8::EpiResF32, pg8::StaticOrder, true, true>((PG8_LAS unsigned char*)smem_all, g, S, E);
    }
    PH_SYNC(5);
    if (PH_RUN(6)) for (int rep = 0; rep < PH_REPS(6); ++rep)
        for (int t = bid; t < P6_ROWITEMS; t += G) phase6_item(p, t);
    PH_SYNC(6);
    if (PH_RUN(7)) for (int rep = 0; rep < PH_REPS(7); ++rep) {
        pg8::Gemm g{(const u16*)(p.ws + OFF_H2), (const u16*)(p.ws + OFF_WT_Q), T_TOK, 2048, 1024}; pg8::StaticOrder S; S.init(T_TOK, 2048, (int)gridDim.x, (int)blockIdx.x);
        pg8::EpiF16 E{(u16*)(p.ws + OFF_QP), 2048};
        pg8::gemm_phase<pg8::EpiF16, pg8::StaticOrder, true, true>((PG8_LAS unsigned char*)smem_all, g, S, E);
    }
    PH_SYNC(7);
    if (PH_RUN(8)) for (int rep = 0; rep < PH_REPS(8); ++rep)
        { peer_score_stage(p, bid & 7, smem); for (int t = bid; t < 512 * 8; t += G) peer_score(p, t, smem); __syncthreads(); }
    PH_SYNC(8);
    if (PH_RUN(9)) for (int rep = 0; rep < PH_REPS(9); ++rep) peer_u_phase(p, smem);
    PH_SYNC(9);
    if (PH_RUN(10)) for (int rep = 0; rep < PH_REPS(10); ++rep) peer_combine_phase(p);
    PH_SYNC(10);
    if (PH_RUN(11)) for (int rep = 0; rep < PH_REPS(11); ++rep) peer_v_phase(p, smem);
}


extern "C" void kernel_launch(void* const* d_in, const int* in_sizes, int n_in, void* d_out, int out_size, void* d_ws, size_t ws_size, hipStream_t stream) {
    (void)in_sizes; (void)n_in; (void)out_size;
    if (ws_size < WS_NEEDED) { fprintf(stderr, "workspace too small: %zu < %zu\n", ws_size, (size_t)WS_NEEDED); return; }
    static int grid_blocks = 0;
    if (!grid_blocks) {
        int dev = 0, cus = 0, per_cu = 0;
        (void)hipGetDevice(&dev);
        (void)hipDeviceGetAttribute(&cus, hipDeviceAttributeMultiprocessorCount, dev);
        if (hipFuncSetAttribute((const void*)hymba_mega, hipFuncAttributeMaxDynamicSharedMemorySize, 2 * SMEM_HALF) != hipSuccess) fprintf(stderr, "hipFuncSetAttribute failed\n");
        (void)hipOccupancyMaxActiveBlocksPerMultiprocessor(&per_cu, hymba_mega, 512, 2 * SMEM_HALF);
        if (per_cu > 1) per_cu = 1;
        if (per_cu < 1) per_cu = 1;
        grid_blocks = cus * per_cu;
    }
    Params p{};
    const float* const* in = (const float* const*)d_in;
    p.x = in[0]; p.norm1_g = in[1]; p.w_in = in[2]; p.conv_w = in[3]; p.conv_b = in[4]; p.wq_m = in[5]; p.wk_m = in[6]; p.ig_b = in[7]; p.fg_b = in[8];
    p.mh_norm_g = in[9]; p.skip_m = in[10]; p.qn_g = in[11]; p.kn_g = in[12]; p.rel_bias = in[13]; p.w_out = in[14]; p.norm2_g = in[15]; p.w_query = in[16];
    p.sub_keys1 = in[17]; p.sub_keys2 = in[18]; p.expert_u = in[19]; p.expert_v = in[20];
    p.out = (float*)d_out; p.ws = (unsigned char*)d_ws;
    (void)hipMemsetAsync((unsigned char*)d_ws + OFF_BAR, 0, XCD_BAR_WORDS * sizeof(unsigned), stream);
    int lo = 0, hi = N_PHASES - 1;
    void* args[] = {(void*)&p, (void*)&lo, (void*)&hi};
    hipError_t e = hipLaunchCooperativeKernel((const void*)hymba_mega, dim3(grid_blocks), dim3(512), args, 2 * SMEM_HALF, stream);
    if (e != hipSuccess) fprintf(stderr, "cooperative launch failed: %s (grid %d)\n", hipGetErrorString(e), grid_blocks);
}
```

```cpp
#include <hip/hip_runtime.h>
#include <cstdio>
#include <cstdint>

typedef unsigned short u16;
typedef short bf16x8 __attribute__((ext_vector_type(8)));
typedef short s16x4 __attribute__((ext_vector_type(4)));
typedef _Float16 f16x8 __attribute__((ext_vector_type(8)));
typedef _Float16 f16x2 __attribute__((ext_vector_type(2)));
typedef float f32x4 __attribute__((ext_vector_type(4)));

#define T_TOK 32768
#define SEQ 8192
#define DM 1024
#define MIB ((size_t)1 << 20)

#define OFF_WT_IN   ((size_t)0)
#define OFF_WT_OUT  (6 * MIB)
#define OFF_WT_Q    (8 * MIB)
#define OFF_WQM     (12 * MIB)
#define OFF_WKM     (12 * MIB + 128 * 1024)
#define OFF_SK1     (12 * MIB + 256 * 1024)
#define OFF_SK2     (12 * MIB + 512 * 1024)
#define OFF_GATES   (13 * MIB)
#define OFF_BCUM    (14 * MIB)
#define OFF_MLOC    (14 * MIB + 512 * 1024)
#define OFF_BLAST   (14 * MIB + 516 * 1024)
#define OFF_MPREV   (14 * MIB + 520 * 1024)
#define OFF_NCH     (15 * MIB)
#define OFF_NPREV   (15 * MIB + 512 * 1024)
#define OFF_LSE     (16 * MIB)
#define OFF_BAR     (19 * MIB)
#define OFF_R0      (24 * MIB)
#define OFF_R1      (88 * MIB)
#define OFF_R2      (280 * MIB)
#define OFF_R3      (312 * MIB)
#define OFF_R4      (376 * MIB)
#define WS_NEEDED   (504 * MIB)

#define OFF_H1   OFF_R0
#define OFF_CH   OFF_R0
#define OFF_QM   (OFF_R0 + 32 * MIB)
#define OFF_H2   OFF_R0
#define OFF_VM   (OFF_R1)
#define OFF_Z    (OFF_R1 + 32 * MIB)
#define OFF_U    (OFF_R1 + 64 * MIB)
#define OFF_QA   (OFF_R1 + 96 * MIB)
#define OFF_KA   (OFF_R1 + 128 * MIB)
#define OFF_VA   (OFF_R1 + 160 * MIB)
#define OFF_CPREV OFF_U
#define OFF_Y    OFF_QA
#define OFF_EU4  (472 * MIB)
#define OFF_SU   (480 * MIB)
#define OFF_EV4  (488 * MIB)
#define OFF_SV   (496 * MIB)
#define OFF_H2Q  OFF_Z
#define OFF_QP   OFF_U
#define OFF_KM   OFF_R2
#define OFF_PIDX OFF_R2
#define OFF_PGATE (OFF_R2 + 16 * MIB)
#define OFF_PSU  OFF_R4
#define OFF_CCH  OFF_R3
#define OFF_ATTO OFF_R4
#define OFF_PPRE OFF_U
#define OFF_AW   OFF_R0
#define OFF_X1   OFF_R3
#define OFF_X1B  OFF_R3
#define OFF_SSP  OFF_LSE
#define OFF_RS   (OFF_LSE + 2 * MIB)

#define SMEM_BYTES 77824

struct Params {
    const float *x, *norm1_g, *w_in, *conv_w, *conv_b, *wq_m, *wk_m, *ig_b, *fg_b, *mh_norm_g, *skip_m,
        *qn_g, *kn_g, *rel_bias, *w_out, *norm2_g, *w_query, *sub_keys1, *sub_keys2, *expert_u, *expert_v;
    float* out;
    unsigned char* ws;
};

__device__ const unsigned char c_bucket[3][132] = {
{0,1,2,3,4,5,6,7,8,9,10,11,12,13,14,15,16,16,16,16,16,16,17,17,17,17,17,17,17,17,18,18,18,18,18,18,18,18,18,18,19,19,19,19,19,19,19,19,19,19,19,19,19,19,20,20,20,20,20,20,20,20,20,20,20,20,20,20,20,20,20,20,20,21,21,21,21,21,21,21,21,21,21,21,21,21,21,21,21,21,21,21,21,21,21,21,21,21,21,22,22,22,22,22,22,22,22,22,22,22,22,22,22,22,22,22,22,22,22,22,22,22,22,22,22,22,22,22,22,0,0,0},
{0,4,8,12,16,16,17,17,18,18,19,19,19,19,20,20,20,20,20,21,21,21,21,21,21,22,22,22,22,22,22,22,22,22,23,23,23,23,23,23,23,23,23,23,23,23,24,24,24,24,24,24,24,24,24,24,24,24,24,24,24,24,25,25,25,25,25,25,25,25,25,25,25,25,25,25,25,25,25,25,25,25,25,26,26,26,26,26,26,26,26,26,26,26,26,26,26,26,26,26,26,26,26,26,26,26,26,26,26,26,26,26,26,27,27,27,27,27,27,27,27,27,27,27,27,27,27,27,27,0,0,0},
{0,16,18,19,20,21,21,22,22,23,23,23,24,24,24,24,25,25,25,25,25,26,26,26,26,26,26,26,26,27,27,27,27,27,27,27,27,27,27,28,28,28,28,28,28,28,28,28,28,28,28,28,29,29,29,29,29,29,29,29,29,29,29,29,29,29,29,29,29,29,30,30,30,30,30,30,30,30,30,30,30,30,30,30,30,30,30,30,30,30,30,30,30,30,30,31,31,31,31,31,31,31,31,31,31,31,31,31,31,31,31,31,31,31,31,31,31,31,31,31,31,31,31,31,31,31,31,31,31,0,0,0}};

__device__ __forceinline__ float bf2f(u16 v) { return __uint_as_float(((unsigned)v) << 16); }
typedef __bf16 bf16x2_t __attribute__((ext_vector_type(2)));
typedef float f32x2_t __attribute__((ext_vector_type(2)));
__device__ __forceinline__ unsigned pk_bf16(float lo, float hi) {
    f32x2_t f; f.x = lo; f.y = hi;
    return __builtin_bit_cast(unsigned, __builtin_convertvector(f, bf16x2_t));
}
__device__ __forceinline__ u16 f2bf(float v) { return (u16)(pk_bf16(v, 0.f) & 0xffffu); }
__device__ __forceinline__ unsigned pk_f16(float lo, float hi) {
    f16x2 h; h.x = (_Float16)lo; h.y = (_Float16)hi; return __builtin_bit_cast(unsigned, h);
}
#define DPP_F(v, ctrl) __int_as_float(__builtin_amdgcn_update_dpp(0, __float_as_int(v), (ctrl), 0xF, 0xF, true))
__device__ __forceinline__ float wave_sum(float v) {
    v += DPP_F(v, 0xB1); v += DPP_F(v, 0x4E); v += DPP_F(v, 0x141); v += DPP_F(v, 0x140);
    v += __shfl_xor(v, 16); v += __shfl_xor(v, 32);
    return v;
}
__device__ __forceinline__ float wave_max(float v) {
    v = fmaxf(v, DPP_F(v, 0xB1)); v = fmaxf(v, DPP_F(v, 0x4E)); v = fmaxf(v, DPP_F(v, 0x141)); v = fmaxf(v, DPP_F(v, 0x140));
    v = fmaxf(v, __shfl_xor(v, 16)); v = fmaxf(v, __shfl_xor(v, 32));
    return v;
}
__device__ __forceinline__ f32x4 mfma_bf16(bf16x8 a, bf16x8 b, f32x4 c) { return __builtin_amdgcn_mfma_f32_16x16x32_bf16(a, b, c, 0, 0, 0); }
__device__ __forceinline__ f32x4 mfma_f16(bf16x8 a, bf16x8 b, f32x4 c) {
    return __builtin_amdgcn_mfma_f32_16x16x32_f16(__builtin_bit_cast(f16x8, a), __builtin_bit_cast(f16x8, b), c, 0, 0, 0);
}

typedef float f32x2 __attribute__((ext_vector_type(2)));
__device__ __forceinline__ unsigned pk4_fp8(float a, float b, float c, float d) {
    int v = 0;
    v = __builtin_amdgcn_cvt_pk_fp8_f32(a, b, v, false);
    v = __builtin_amdgcn_cvt_pk_fp8_f32(c, d, v, true);
    return (unsigned)v;
}
__device__ __forceinline__ f32x4 mfma_fp8(long a, long b, f32x4 c) { return __builtin_amdgcn_mfma_f32_16x16x32_fp8_fp8(a, b, c, 0, 0, 0); }
__device__ __forceinline__ float sigmoidf_(float v) { return __builtin_amdgcn_rcpf(1.0f + __expf(-v)); }
__device__ __forceinline__ float log_sigmoid(float v) { return fminf(v, 0.f) - __logf(1.0f + __expf(-fabsf(v))); }
__device__ __forceinline__ void unpack8_bf16(uint4 v, float* f) {
    f[0] = __uint_as_float(v.x << 16); f[1] = __uint_as_float(v.x & 0xffff0000u);
    f[2] = __uint_as_float(v.y << 16); f[3] = __uint_as_float(v.y & 0xffff0000u);
    f[4] = __uint_as_float(v.z << 16); f[5] = __uint_as_float(v.z & 0xffff0000u);
    f[6] = __uint_as_float(v.w << 16); f[7] = __uint_as_float(v.w & 0xffff0000u);
}
typedef __attribute__((address_space(3))) s16x4 lds_s16x4;
__device__ __forceinline__ s16x4 ld_tr(const u16* p) { return __builtin_amdgcn_ds_read_tr16_b64_v4i16((lds_s16x4*)p); }
__device__ __forceinline__ bf16x8 cat4(s16x4 lo, s16x4 hi) { return __builtin_shufflevector(lo, hi, 0, 1, 2, 3, 4, 5, 6, 7); }


#define XB_TMO      128
#define XB_XCNT(j)  (256  + 64 * (j))
#define XB_XSUB(j)  (1280 + 64 * (j))
#define XB_XGEN(j)  (2304 + 64 * (j))
#define XB_TOP      3328
#define XB_TOPGEN   3392
#define XCD_BAR_WORDS 3456
#define XB_SPIN_CAP (1u << 22)
#define LAS __attribute__((address_space(3)))
__device__ __forceinline__ unsigned xb_ld(unsigned* p)              { return __hip_atomic_load(p, __ATOMIC_RELAXED, __HIP_MEMORY_SCOPE_AGENT); }
__device__ __forceinline__ unsigned xb_add(unsigned* p, unsigned v) { return __hip_atomic_fetch_add(p, v, __ATOMIC_RELAXED, __HIP_MEMORY_SCOPE_AGENT); }
__device__ __forceinline__ unsigned xb_xcc_id() { return (unsigned)__builtin_amdgcn_s_getreg((3 << 11) | 20) & 0xFu; }
#define XB_SPIN(cond, bar) do { unsigned _sp = 0; while (cond) { __builtin_amdgcn_s_sleep(1); \
    if ((++_sp & 255u) == 0u) { if (xb_ld(&(bar)[XB_TMO])) break; if (_sp > XB_SPIN_CAP) { atomicAdd(&(bar)[XB_TMO], 1u); break; } } } } while (0)
struct XcdBarrier { unsigned* bar; unsigned x; volatile unsigned* st; };
__device__ __forceinline__ XcdBarrier xcd_barrier_post(unsigned* bar, volatile unsigned* st) {
    XcdBarrier b; b.bar = bar; b.x = xb_xcc_id(); b.st = st;
    if (threadIdx.x == 0) (void)xb_add(&bar[XB_XCNT(b.x)], 1u);
    return b;
}
__device__ __forceinline__ void xcd_barrier_complete(unsigned* bar, unsigned x, unsigned& nloc, unsigned& nx) {
    const unsigned G = gridDim.x * gridDim.y * gridDim.z;
    unsigned sum, cnt, mine, sp = 0u;
    for (;;) {
        sum = 0u; cnt = 0u; mine = 0u;
#pragma unroll
        for (unsigned j = 0; j < 16; ++j) { const unsigned c = xb_ld(&bar[XB_XCNT(j)]); sum += c; cnt += (c > 0u) ? 1u : 0u; mine = (j == x) ? c : mine; }
        if (sum == G) break;
        __builtin_amdgcn_s_sleep(1);
        if ((++sp & 255u) == 0u) { if (xb_ld(&bar[XB_TMO])) break; if (sp > XB_SPIN_CAP) { atomicAdd(&bar[XB_TMO], 1u); break; } }
    }
    nloc = mine > 0u ? mine : 1u; nx = cnt > 0u ? cnt : 1u;
}
__device__ __forceinline__ void xcd_barrier(const XcdBarrier& b) {
    asm volatile("s_waitcnt vmcnt(0)" ::: "memory");
    __syncthreads();
    if (threadIdx.x == 0) {
        unsigned* bar = b.bar;
        __builtin_amdgcn_s_waitcnt(0);
        unsigned nloc = b.st[0], nx = b.st[1];
        if (nloc == 0u) { xcd_barrier_complete(bar, b.x, nloc, nx); b.st[0] = nloc; b.st[1] = nx; }
        const unsigned old = xb_add(&bar[XB_XSUB(b.x)], 1u);
        const unsigned gen = old / nloc;
        if (old + 1u == (gen + 1u) * nloc) {
            __builtin_amdgcn_fence(__ATOMIC_RELEASE, "agent");
            asm volatile("s_waitcnt vmcnt(0)" ::: "memory");
            const unsigned og = xb_add(&bar[XB_TOP], 1u);
            const unsigned tg = og / nx;
            if (og + 1u == (tg + 1u) * nx) xb_add(&bar[XB_TOPGEN], 1u);
            else XB_SPIN(xb_ld(&bar[XB_TOPGEN]) == tg, bar);
            __builtin_amdgcn_fence(__ATOMIC_ACQUIRE, "agent");
            xb_add(&bar[XB_XGEN(b.x)], 1u);
            asm volatile("s_waitcnt vmcnt(0)" ::: "memory");
        } else {
            XB_SPIN(xb_ld(&bar[XB_XGEN(b.x)]) == gen, bar);
            __builtin_amdgcn_fence(__ATOMIC_ACQUIRE, "agent");
            asm volatile("s_waitcnt vmcnt(0)" ::: "memory");
        }
    }
    __syncthreads();
}


#define TIDX ((int)(threadIdx.x & 255u))
#define HALFID ((int)(threadIdx.x >> 8))
#define VBID ((int)(blockIdx.x * 2u + (threadIdx.x >> 8)))
#define VGRID ((int)(gridDim.x * 2u))
#define SMEM_HALF 77824

namespace pg8 {
#define PG8_LAS __attribute__((address_space(3)))
typedef unsigned short bf16_t;
typedef short bf16x8 __attribute__((ext_vector_type(8)));
typedef float f32x4 __attribute__((ext_vector_type(4)));
typedef unsigned u32x4 __attribute__((ext_vector_type(4)));
constexpr int BM = 256, BK = 64, HALF = 128, HTB = HALF * BK * 2  , STAGE_BYTES = 8 * HTB, NXCD = 8, WGM = 8;

__host__ __device__ __forceinline__ int lds_byte(int r, int c) { const int st = (r >> 4) * 2 + (c >> 5), rr = r & 15, cc = c & 31, ob = rr * 64 + cc * 2; return st * 1024 + (ob ^ (((ob >> 9) & 1) << 5)); }
__host__ __device__ __forceinline__ void stage_rc(int b, int& R, int& C) { const int st = b / 1024, sb = b % 1024, swz = sb ^ (((sb >> 9) & 1) << 5); R = (st >> 1) * 16 + swz / 64; C = (st & 1) * 32 + (swz % 64) / 2; }
__host__ __device__ __forceinline__ int perm32(int rho) { const int n = rho >> 4, i = rho & 15; return 8 * (i >> 2) + 4 * n + (i & 3); }

struct Unit { int pm, pn; };
struct Gemm { const bf16_t* A; const bf16_t* Bt; int M, N, K; };

struct StaticOrder {
    int nM, nN, nwg, G, c;
    __host__ __device__ void init(int M, int N, int G_, int c_) { nM = M / BM; nN = N / BM; nwg = nM * nN; G = G_; c = c_; }
    __host__ __device__ bool next(int i, Unit& u) const {
        const long L = (long)i * G + c; if (L >= nwg) return false;
        int wgid = (int)L; { const int q = nwg / NXCD, r = nwg % NXCD, xcd = wgid % NXCD, off = wgid / NXCD; wgid = (xcd < r ? xcd * (q + 1) : r * (q + 1) + (xcd - r) * q) + off; }
        const int nig = WGM * nN, gid = wgid / nig, fm = gid * WGM, gsz = (nM - fm) < WGM ? (nM - fm) : WGM;
        u.pm = fm + ((wgid % nig) % gsz); u.pn = (wgid % nig) / gsz; return true;
    }
    __device__ __forceinline__ void a_ready(const Unit&) const {}
    __device__ __forceinline__ void done(const Unit&) const {}
};

__device__ __forceinline__ unsigned cvt_pk_bf16(float lo, float hi) { return ::pk_bf16(lo, hi); }
typedef float f32x2 __attribute__((ext_vector_type(2)));
__device__ __forceinline__ f32x2 gelu_pk(f32x2 v) {
    const f32x2 av = __builtin_elementwise_abs(v), d = av * 0.2316418882f + 1.0f;
    f32x2 t; t.x = __builtin_amdgcn_rcpf(d.x); t.y = __builtin_amdgcn_rcpf(d.y);
    f32x2 q = t * 0.5307027145f + (-0.7265760135f); q = q * t + 0.7107068705f; q = q * t + (-0.142248368f); q = q * t + 0.127414796f; q = q * t;
    const f32x2 s = (v * v) * (-0.72134752044f);
    f32x2 e; e.x = __builtin_amdgcn_exp2f(s.x); e.y = __builtin_amdgcn_exp2f(s.y);
    const f32x2 m = v * (q * e), r = v - m;
    f32x2 o; o.x = v.x < 0.f ? m.x : r.x; o.y = v.y < 0.f ? m.y : r.y; return o;
}
template <int ACT  > struct EpiBf16 {
    static constexpr bool PERM = true, AFTER_DRAIN = false; static_assert(ACT == 0 || ACT == 1, "EpiBf16: ACT is 0 (none) or 1 (gelu_pk)");
    bf16_t* O; int ldc; const float* bias; int split_cols; size_t split_stride; float scale0;
    __device__ __forceinline__ void operator()(const f32x4 (&acc)[2][2][4][2], const Unit& u, int wr, int wc, int fr, int fq) const {
        const int row0 = u.pm * BM + wr * 64 + fr; int colt = u.pn * BM; bf16_t* base = O;
        float sc = 1.f; if (split_cols) { const int t = colt / split_cols; base += (size_t)t * split_stride; colt -= t * split_cols; if (t == 0) sc = scale0; }
        const int col0 = colt + wc * 32 + 8 * fq, bcol0 = u.pn * BM + wc * 32 + 8 * fq;
        f32x4 bv[2][2];
#pragma unroll
        for (int bj = 0; bj < 2; ++bj)
#pragma unroll
            for (int n = 0; n < 2; ++n) bv[bj][n] = bias ? *(const f32x4*)(bias + bcol0 + bj * HALF + 4 * n) : (f32x4){0.f, 0.f, 0.f, 0.f};
#pragma unroll
        for (int ai = 0; ai < 2; ++ai)
#pragma unroll
            for (int m = 0; m < 4; ++m) { bf16_t* rowp = base + (size_t)(row0 + ai * HALF + m * 16) * ldc + col0;
#pragma unroll
                for (int bj = 0; bj < 2; ++bj) { f32x4 v0 = acc[ai][bj][m][0] + bv[bj][0], v1 = acc[ai][bj][m][1] + bv[bj][1];
                    if (ACT == 1) { f32x2 a = gelu_pk((f32x2){v0[0], v0[1]}), b = gelu_pk((f32x2){v0[2], v0[3]}), c = gelu_pk((f32x2){v1[0], v1[1]}), d = gelu_pk((f32x2){v1[2], v1[3]});
                        v0 = (f32x4){a.x, a.y, b.x, b.y}; v1 = (f32x4){c.x, c.y, d.x, d.y}; }
                    v0 = v0 * sc; v1 = v1 * sc; u32x4 w; w.x = cvt_pk_bf16(v0[0], v0[1]); w.y = cvt_pk_bf16(v0[2], v0[3]); w.z = cvt_pk_bf16(v1[0], v1[1]); w.w = cvt_pk_bf16(v1[2], v1[3]);
                    *(u32x4*)(rowp + bj * HALF) = w; } }
    }
};
template <class Epi, class Sched, bool ALIGN_EPI = false, bool SP2 = false>
__device__ __forceinline__ void gemm_phase(PG8_LAS unsigned char* lds, const Gemm g, const Sched& S, const Epi& E) {
    const int tid = threadIdx.x, wid = __builtin_amdgcn_readfirstlane(tid >> 6), lane = tid & 63, wr = wid >> 2, wc = wid & 3, fr = lane & 15, fq = lane >> 4;
    const int K = g.K, nt = K / BK;
    unsigned voffA[2], voffB[2];
#pragma unroll
    for (int i = 0; i < 2; ++i) { int R, C; stage_rc(tid * 16 + i * 8192, R, C); const int Rb = Epi::PERM ? ((R & ~31) + perm32(R & 31)) : R;
        voffA[i] = (unsigned)(R * K + C) * 2u; voffB[i] = (unsigned)(Rb * K + C) * 2u; }
    const size_t kstep = (size_t)(BK * 2);
    const size_t hstep = (size_t)HALF * K * 2;
    const size_t tstep = 2 * hstep;
    const unsigned ldsw = (unsigned)wid * 1024u;
    const int aoff = lds_byte(wr * 64 + fr, fq * 8), boff = lds_byte(wc * 32 + fr, fq * 8);
#define PG8_SA(b, h) (((b) * 2 + (h)) * HTB)
#define PG8_SB(b, h) ((4 + (b) * 2 + (h)) * HTB)
#define PG8_STAGE(bufoff, gbase, voff) do { _Pragma("unroll") for (int _i = 0; _i < 2; ++_i) \
        __builtin_amdgcn_global_load_lds((const unsigned*)((const char*)(gbase) + (voff)[_i]), (PG8_LAS unsigned*)(lds + (bufoff) + ldsw + _i * 8192), 16, 0, 0); } while (0)
#define PG8_LDA(dst, b, h) do { _Pragma("unroll") for (int m = 0; m < 4; ++m) _Pragma("unroll") for (int k = 0; k < 2; ++k) dst[m][k] = *(const PG8_LAS bf16x8*)(lds + PG8_SA(b, h) + aoff + m * 2048 + k * 1024); } while (0)
#define PG8_LDB(dst, b, h) do { _Pragma("unroll") for (int n = 0; n < 2; ++n) _Pragma("unroll") for (int k = 0; k < 2; ++k) dst[n][k] = *(const PG8_LAS bf16x8*)(lds + PG8_SB(b, h) + boff + n * 2048 + k * 1024); } while (0)
#define PG8_MMA(ai, bj, At, Bt) do { __builtin_amdgcn_s_setprio(1); _Pragma("unroll") for (int m = 0; m < 4; ++m) _Pragma("unroll") for (int n = 0; n < 2; ++n) _Pragma("unroll") for (int k = 0; k < 2; ++k) \
        acc[ai][bj][m][n] = __builtin_amdgcn_mfma_f32_16x16x32_bf16(Bt[n][k], At[m][k], acc[ai][bj][m][n], 0, 0, 0); __builtin_amdgcn_s_setprio(0); } while (0)
#define PG8_WAIT_V(n) asm volatile("s_waitcnt vmcnt(" #n ")" ::: "memory")
#define PG8_WAIT_L(n) asm volatile("s_waitcnt lgkmcnt(" #n ")" ::: "memory")
#define PG8_BAR __builtin_amdgcn_s_barrier()
#define PG8_SCHED __builtin_amdgcn_sched_barrier(0)
    Unit cur, nxt; int ui = 0;
    if (!S.next(0, cur)) return;
    f32x4 acc[2][2][4][2];
#pragma unroll
    for (int a = 0; a < 2; ++a)
#pragma unroll
        for (int b = 0; b < 2; ++b)
#pragma unroll
            for (int m = 0; m < 4; ++m)
#pragma unroll
                for (int n = 0; n < 2; ++n) acc[a][b][m][n] = (f32x4){0.f, 0.f, 0.f, 0.f};
    bf16x8 At[4][2], B0[2][2], B1[2][2];
    const char* cA = (const char*)g.A + (size_t)cur.pm * tstep; const char* cB = (const char*)g.Bt + (size_t)cur.pn * tstep;
    S.a_ready(cur);
    if constexpr (SP2) {
        PG8_STAGE(PG8_SB(0, 0), cB, voffB); PG8_STAGE(PG8_SB(0, 1), cB + hstep, voffB); PG8_STAGE(PG8_SA(0, 0), cA, voffA); PG8_STAGE(PG8_SA(0, 1), cA + hstep, voffA);
        if (wr == 1) PG8_BAR;
        PG8_WAIT_V(2); PG8_BAR;
        PG8_STAGE(PG8_SB(1, 0), cB + kstep, voffB); PG8_STAGE(PG8_SA(1, 0), cA + kstep, voffA); PG8_STAGE(PG8_SB(1, 1), cB + hstep + kstep, voffB);
        PG8_WAIT_V(6); PG8_BAR;
    } else {
        PG8_STAGE(PG8_SB(0, 0), cB, voffB); PG8_STAGE(PG8_SA(0, 0), cA, voffA); PG8_STAGE(PG8_SB(0, 1), cB + hstep, voffB); PG8_STAGE(PG8_SA(0, 1), cA + hstep, voffA);
        if (wr == 1) PG8_BAR;
        PG8_WAIT_V(4); PG8_BAR;
        PG8_STAGE(PG8_SB(1, 0), cB + kstep, voffB); PG8_STAGE(PG8_SA(1, 0), cA + kstep, voffA); PG8_STAGE(PG8_SB(1, 1), cB + hstep + kstep, voffB);
        PG8_WAIT_V(6); PG8_BAR;
    }
    for (;;) {
        const bool has_next = S.next(ui + 1, nxt);
        const char* nA = has_next ? (const char*)g.A + (size_t)nxt.pm * tstep : cA; const char* nB = has_next ? (const char*)g.Bt + (size_t)nxt.pn * tstep : cB;
        for (int t = 0; t < nt; t += 2) {
            const bool last = (t == nt - 2);
            const char* a1 = cA + (size_t)(t + 1) * kstep;
            const char* a2 = last ? nA : cA + (size_t)(t + 2) * kstep; const char* b2 = last ? nB : cB + (size_t)(t + 2) * kstep;
            const char* a3 = a2 + kstep; const char* b3 = b2 + kstep;
            if (last && has_next) S.a_ready(nxt);
            if constexpr (SP2) {
            PG8_LDB(B0, 0, 0); PG8_LDB(B1, 0, 1); PG8_SCHED; PG8_LDA(At, 0, 0); PG8_STAGE(PG8_SA(1, 1), a1 + hstep, voffA);
            PG8_WAIT_V(8); PG8_WAIT_L(0); PG8_BAR; PG8_MMA(0, 0, At, B0); PG8_MMA(0, 1, At, B1); PG8_BAR; PG8_SCHED;
            PG8_LDA(At, 0, 1); PG8_STAGE(PG8_SB(0, 0), b2, voffB); PG8_STAGE(PG8_SB(0, 1), b2 + hstep, voffB); PG8_STAGE(PG8_SA(0, 0), a2, voffA);
            PG8_WAIT_V(8); PG8_WAIT_L(0); PG8_BAR; PG8_MMA(1, 0, At, B0); PG8_MMA(1, 1, At, B1); PG8_BAR; PG8_SCHED;
            PG8_LDB(B0, 1, 0); PG8_LDB(B1, 1, 1); PG8_SCHED; PG8_LDA(At, 1, 0); PG8_STAGE(PG8_SA(0, 1), a2 + hstep, voffA);
            PG8_WAIT_V(8); PG8_WAIT_L(0); PG8_BAR; PG8_MMA(0, 0, At, B0); PG8_MMA(0, 1, At, B1); PG8_BAR; PG8_SCHED;
            PG8_LDA(At, 1, 1); PG8_STAGE(PG8_SB(1, 0), b3, voffB); PG8_STAGE(PG8_SB(1, 1), b3 + hstep, voffB); PG8_STAGE(PG8_SA(1, 0), a3, voffA);
            PG8_WAIT_V(8); PG8_WAIT_L(0); PG8_BAR; PG8_MMA(1, 0, At, B0); PG8_MMA(1, 1, At, B1); PG8_BAR; PG8_SCHED;
            } else {
            PG8_LDB(B0, 0, 0); PG8_SCHED; PG8_LDA(At, 0, 0); PG8_STAGE(PG8_SA(1, 1), a1 + hstep, voffA);
            PG8_WAIT_L(8); PG8_BAR; PG8_WAIT_L(0); PG8_MMA(0, 0, At, B0); PG8_BAR; PG8_SCHED;
            PG8_LDB(B1, 0, 1); PG8_STAGE(PG8_SB(0, 0), b2, voffB);
            PG8_BAR; PG8_WAIT_L(0); PG8_MMA(0, 1, At, B1); PG8_BAR;
            PG8_LDA(At, 0, 1); PG8_STAGE(PG8_SA(0, 0), a2, voffA);
            PG8_BAR; PG8_WAIT_L(0); PG8_MMA(1, 0, At, B0); PG8_BAR; PG8_SCHED;
            PG8_STAGE(PG8_SB(0, 1), b2 + hstep, voffB);
            PG8_WAIT_V(6); PG8_BAR; PG8_MMA(1, 1, At, B1); PG8_BAR;
            PG8_LDB(B0, 1, 0); PG8_SCHED; PG8_LDA(At, 1, 0); PG8_STAGE(PG8_SA(0, 1), a2 + hstep, voffA);
            PG8_WAIT_L(8); PG8_BAR; PG8_WAIT_L(0); PG8_MMA(0, 0, At, B0); PG8_BAR; PG8_SCHED;
            PG8_LDB(B1, 1, 1); PG8_STAGE(PG8_SB(1, 0), b3, voffB);
            PG8_BAR; PG8_WAIT_L(0); PG8_MMA(0, 1, At, B1); PG8_BAR;
            PG8_LDA(At, 1, 1); PG8_STAGE(PG8_SA(1, 0), a3, voffA);
            PG8_BAR; PG8_WAIT_L(0); PG8_MMA(1, 0, At, B0); PG8_BAR; PG8_SCHED;
            PG8_STAGE(PG8_SB(1, 1), b3 + hstep, voffB);
            PG8_WAIT_V(6); PG8_BAR; PG8_MMA(1, 1, At, B1); PG8_BAR;
            }
        }
        if constexpr (ALIGN_EPI) { if (wr == 0) PG8_BAR; }
        if constexpr (!Epi::AFTER_DRAIN) { E(acc, cur, wr, wc, fr, fq); S.done(cur); }
        if (!has_next) break;
#pragma unroll
        for (int a = 0; a < 2; ++a)
#pragma unroll
            for (int b = 0; b < 2; ++b)
#pragma unroll
                for (int m = 0; m < 4; ++m)
#pragma unroll
                    for (int n = 0; n < 2; ++n) acc[a][b][m][n] = (f32x4){0.f, 0.f, 0.f, 0.f};
        cur = nxt; cA = nA; cB = nB; ++ui;
        if constexpr (ALIGN_EPI) { if (wr == 1) PG8_BAR; }
    }
    PG8_WAIT_V(0);
    if constexpr (!ALIGN_EPI) { if (wr == 0) PG8_BAR; }
    PG8_BAR;
    if constexpr (Epi::AFTER_DRAIN) { E.fused(acc, cur, wr, wc, fr, fq, lds, wid, lane); S.done(cur); }
#undef PG8_SA
#undef PG8_SB
#undef PG8_STAGE
#undef PG8_LDA
#undef PG8_LDB
#undef PG8_MMA
#undef PG8_WAIT_V
#undef PG8_WAIT_L
#undef PG8_BAR
#undef PG8_SCHED
}

struct EpiResF32 {
    static constexpr bool PERM = false, AFTER_DRAIN = false;
    const float* base; float* out; int ldc;
    __device__ __forceinline__ void operator()(const f32x4 (&acc)[2][2][4][2], const Unit& u, int wr, int wc, int fr, int fq) const {
        const int col0 = u.pn * BM + wc * 32 + 4 * fq;
#pragma unroll
        for (int ai = 0; ai < 2; ++ai)
#pragma unroll
            for (int m = 0; m < 4; ++m) {
                const size_t off = (size_t)(u.pm * BM + ai * HALF + wr * 64 + m * 16 + fr) * ldc + col0;
#pragma unroll
                for (int bj = 0; bj < 2; ++bj)
#pragma unroll
                    for (int n = 0; n < 2; ++n) {
                        const f32x4 bs = *(const f32x4*)(base + off + bj * HALF + n * 16);
                        *(f32x4*)(out + off + bj * HALF + n * 16) = bs + acc[ai][bj][m][n];
                    }
            }
    }
};
struct EpiF16 {
    static constexpr bool PERM = true, AFTER_DRAIN = false;
    bf16_t* O; int ldc;
    __device__ __forceinline__ void operator()(const f32x4 (&acc)[2][2][4][2], const Unit& u, int wr, int wc, int fr, int fq) const {
        const int row0 = u.pm * BM + wr * 64 + fr, col0 = u.pn * BM + wc * 32 + 8 * fq;
#pragma unroll
        for (int ai = 0; ai < 2; ++ai)
#pragma unroll
            for (int m = 0; m < 4; ++m) {
                bf16_t* rowp = O + (size_t)(row0 + ai * HALF + m * 16) * ldc + col0;
#pragma unroll
                for (int bj = 0; bj < 2; ++bj) {
                    const f32x4 v0 = acc[ai][bj][m][0], v1 = acc[ai][bj][m][1];
                    u32x4 w; w.x = ::pk_f16(v0[0], v0[1]); w.y = ::pk_f16(v0[2], v0[3]); w.z = ::pk_f16(v1[0], v1[1]); w.w = ::pk_f16(v1[2], v1[3]);
                    *(u32x4*)(rowp + bj * HALF) = w;
                }
            }
    }
};
struct EpiResX1 {
    static constexpr bool PERM = true, AFTER_DRAIN = false, FP8 = false;
    const float* base; bf16_t* xb; unsigned char* xq; const float* g2; float* ssp; int ldc;
    __device__ __forceinline__ void operator()(const f32x4 (&acc)[2][2][4][2], const Unit& u, int wr, int wc, int fr, int fq) const {
        const int col0 = u.pn * BM + wc * 32 + 8 * fq;
        f32x4 gg[2][2];
#pragma unroll
        for (int bj = 0; bj < 2; ++bj) { gg[bj][0] = *(const f32x4*)(g2 + col0 + bj * HALF) * 16.f; gg[bj][1] = *(const f32x4*)(g2 + col0 + bj * HALF + 4) * 16.f; }
#pragma unroll
        for (int ai = 0; ai < 2; ++ai)
#pragma unroll
            for (int m = 0; m < 4; ++m) {
                const int row = u.pm * BM + ai * HALF + wr * 64 + m * 16 + fr;
                const size_t off = (size_t)row * ldc + col0;
                float ss = 0.f;
#pragma unroll
                for (int bj = 0; bj < 2; ++bj) {
                    const f32x4 v0 = *(const f32x4*)(base + off + bj * HALF) + acc[ai][bj][m][0], v1 = *(const f32x4*)(base + off + bj * HALF + 4) + acc[ai][bj][m][1];
                    ss += v0[0] * v0[0] + v0[1] * v0[1] + v0[2] * v0[2] + v0[3] * v0[3] + v1[0] * v1[0] + v1[1] * v1[1] + v1[2] * v1[2] + v1[3] * v1[3];
                    u32x4 w; w.x = ::pk_bf16(v0[0], v0[1]); w.y = ::pk_bf16(v0[2], v0[3]); w.z = ::pk_bf16(v1[0], v1[1]); w.w = ::pk_bf16(v1[2], v1[3]);
                    *(u32x4*)(xb + off + bj * HALF) = w;
                    const f32x4 q0 = v0 * gg[bj][0], q1 = v1 * gg[bj][1];
                    uint2 q; q.x = ::pk4_fp8(q0[0], q0[1], q0[2], q0[3]); q.y = ::pk4_fp8(q1[0], q1[1], q1[2], q1[3]);
                    *(uint2*)(xq + off + bj * HALF) = q;
                }
                ss += __shfl_xor(ss, 16); ss += __shfl_xor(ss, 32);
                if (fq == 0) ssp[(size_t)(u.pn * 4 + wc) * 32768 + row] = ss;
            }
    }
};
struct EpiF16S {
    static constexpr bool PERM = true, AFTER_DRAIN = false;
    bf16_t* O; int ldc; const float* ssp; float* rs_out;
    __device__ __forceinline__ void operator()(const f32x4 (&acc)[2][2][4][2], const Unit& u, int wr, int wc, int fr, int fq) const {
        const int row0 = u.pm * BM + wr * 64 + fr, col0 = u.pn * BM + wc * 32 + 8 * fq;
#pragma unroll
        for (int ai = 0; ai < 2; ++ai)
#pragma unroll
            for (int m = 0; m < 4; ++m) {
                const int row = row0 + ai * HALF + m * 16;
                float ss = 0.f;
#pragma unroll
                for (int j = 0; j < 16; ++j) ss += ssp[(size_t)j * 32768 + row];
                const float rs = rsqrtf(ss * (1.0f / 1024.0f) + 1e-6f);
                if (u.pn == 0 && wc == 0 && fq == 0) rs_out[row] = rs;
                bf16_t* rowp = O + (size_t)row * ldc + col0;
#pragma unroll
                for (int bj = 0; bj < 2; ++bj) {
                    const f32x4 v0 = acc[ai][bj][m][0] * rs, v1 = acc[ai][bj][m][1] * rs;
                    u32x4 w; w.x = ::pk_f16(v0[0], v0[1]); w.y = ::pk_f16(v0[2], v0[3]); w.z = ::pk_f16(v1[0], v1[1]); w.w = ::pk_f16(v1[2], v1[3]);
                    *(u32x4*)(rowp + bj * HALF) = w;
                }
            }
    }
};
}

#define P0_NTR 1632
#define P0_ITEMS (P0_NTR + T_TOK / 8)

__device__ __forceinline__ void tr_tile(const float* __restrict__ src, int ld_src, int k0, int c0, u16* __restrict__ dst, int ld_dst, int n0,
                                        float scale_, bool f16, float* tile, const float* __restrict__ rowscale = nullptr) {
    const int tid = TIDX;
#pragma unroll
    for (int i = 0; i < 4; ++i) {
        const int idx = tid + 256 * i, r = idx >> 4, c = (idx & 15) * 4;
        const float4 v = *(const float4*)(src + (size_t)(k0 + r) * ld_src + c0 + c);
        const float scale = rowscale ? scale_ * rowscale[k0 + r] : scale_;
        tile[r * 65 + c] = v.x * scale; tile[r * 65 + c + 1] = v.y * scale; tile[r * 65 + c + 2] = v.z * scale; tile[r * 65 + c + 3] = v.w * scale;
    }
    __syncthreads();
#pragma unroll
    for (int i = 0; i < 8; ++i) {
        const int idx = tid + 256 * i, c = idx >> 5, r = (idx & 31) * 2;
        const float a = tile[r * 65 + c], b = tile[(r + 1) * 65 + c];
        const unsigned w = f16 ? pk_f16(a, b) : pk_bf16(a, b);
        *(unsigned*)(dst + (size_t)(n0 + c) * ld_dst + k0 + r) = w;
    }
    __syncthreads();
}

#define SWQ 64.0f
__device__ __forceinline__ void tr_tile_fp8(const float* __restrict__ src, int ld_src, int k0, int c0, unsigned char* __restrict__ dst, int ld_dst, int n0, float scale, float* tile) {
    const int tid = TIDX;
#pragma unroll
    for (int i = 0; i < 4; ++i) {
        const int idx = tid + 256 * i, r = idx >> 4, c = (idx & 15) * 4;
        const float4 v = *(const float4*)(src + (size_t)(k0 + r) * ld_src + c0 + c);
        tile[r * 65 + c] = v.x * scale; tile[r * 65 + c + 1] = v.y * scale; tile[r * 65 + c + 2] = v.z * scale; tile[r * 65 + c + 3] = v.w * scale;
    }
    __syncthreads();
#pragma unroll
    for (int i = 0; i < 4; ++i) {
        const int idx = tid + 256 * i, c = idx >> 4, r = (idx & 15) * 4;
        *(unsigned*)(dst + (size_t)(n0 + c) * ld_dst + k0 + r) = pk4_fp8(tile[r * 65 + c], tile[(r + 1) * 65 + c], tile[(r + 2) * 65 + c], tile[(r + 3) * 65 + c]);
    }
    __syncthreads();
}

__device__ void phase0(const Params& p, unsigned char* smem) {
    int tid_ = TIDX; asm volatile("" : "+v"(tid_)); const int tid = tid_, lane = tid & 63, wave = __builtin_amdgcn_readfirstlane(tid >> 6);
    float* tile = (float*)smem;
    float* sG = (float*)(smem + 17408);
    bool staged = false;
    for (int item = VBID; item < P0_ITEMS; item += VGRID) {
        if (item < P0_NTR) {
            int it = item;
            if (it < 768) {
                const int kt = it & 15, nt = it >> 4, n0 = nt * 64, arr = n0 >> 9, within = n0 & 511;
                const int srcc = (arr == 0 ? 512 : arr == 1 ? 1024 : arr == 2 ? 0 : arr == 3 ? 1544 : arr == 4 ? 2056 : 2568) + within;
                tr_tile(p.w_in, 3080, kt * 64, srcc, (u16*)(p.ws + OFF_WT_IN), 1024, n0, 1.0f, false, tile);
                continue;
            }
            it -= 768;
            if (it < 256) { tr_tile(p.w_out, 1024, (it & 15) * 64, (it >> 4) * 64, (u16*)(p.ws + OFF_WT_OUT), 1024, (it >> 4) * 64, 1.0f, false, tile); continue; }
            it -= 256;
            if (it < 512) { tr_tile_fp8(p.w_query, 2048, (it & 15) * 64, (it >> 4) * 64, p.ws + OFF_WT_Q, 1024, (it >> 4) * 64, SWQ, tile); continue; }
            it -= 512;
            if (it < 32) {
                const int which = it >> 4, hh = (it >> 2) & 3, kt = (it >> 1) & 1, nt = it & 1;
                const float* src = (which ? p.wk_m : p.wq_m) + hh * 16384;
                u16* dst = (u16*)(p.ws + (which ? OFF_WKM : OFF_WQM)) + hh * 16384;
                tr_tile(src, 128, kt * 64, nt * 64, dst, 128, nt * 64, which ? 0.08838834764831845f : 1.0f, false, tile);
                continue;
            }
            it -= 32;
            {
                const int which = it >> 5, part = it & 31;
                const float* src = (which ? p.sub_keys2 : p.sub_keys1) + part * 4096;
                u16* dst = (u16*)(p.ws + (which ? OFF_SK2 : OFF_SK1)) + part * 4096;
#pragma unroll
                for (int i = 0; i < 4; ++i) {
                    const int e = (tid + 256 * i) * 4;
                    const float4 v = *(const float4*)(src + e);
                    uint2 w; w.x = pk_f16(v.x, v.y); w.y = pk_f16(v.z, v.w);
                    *(uint2*)(dst + e) = w;
                }
            }
            continue;
        }
        if (!staged) {
            for (int i = tid; i < 1024 * 2; i += 256) {
                const int k = i >> 1, hf = i & 1, slot = ((k >> 8) * 4 + (k & 3)) * 64 + ((k >> 2) & 63);
                *(float4*)(sG + hf * 4096 + slot * 4) = *(const float4*)(p.w_in + (size_t)k * 3080 + 1536 + hf * 4);
            }
            __syncthreads();
            staged = true;
        }
        const int row0 = (item - P0_NTR) * 8 + wave * 2;
        float4 v[2][4];
        float ss[2] = {0.f, 0.f};
#pragma unroll
        for (int rr = 0; rr < 2; ++rr) {
            const float4* xr = (const float4*)(p.x + (size_t)(row0 + rr) * DM);
#pragma unroll
            for (int j = 0; j < 4; ++j) v[rr][j] = xr[lane + 64 * j];
        }
#pragma unroll
        for (int rr = 0; rr < 2; ++rr)
#pragma unroll
            for (int j = 0; j < 4; ++j) ss[rr] += v[rr][j].x * v[rr][j].x + v[rr][j].y * v[rr][j].y + v[rr][j].z * v[rr][j].z + v[rr][j].w * v[rr][j].w;
        ss[0] = wave_sum(ss[0]); ss[1] = wave_sum(ss[1]);
        {
            const float rs0 = rsqrtf(ss[0] * (1.0f / 1024.0f) + 1e-6f), rs1 = rsqrtf(ss[1] * (1.0f / 1024.0f) + 1e-6f);
            float ga[2][8];
#pragma unroll
            for (int c = 0; c < 8; ++c) { ga[0][c] = 0.f; ga[1][c] = 0.f; }
            u16* h1a = (u16*)(p.ws + OFF_H1) + (size_t)row0 * DM;
#pragma unroll
            for (int j = 0; j < 4; ++j) {
                const float4 g = ((const float4*)p.norm1_g)[lane + 64 * j];
                const float ya[4] = {v[0][j].x * rs0 * g.x, v[0][j].y * rs0 * g.y, v[0][j].z * rs0 * g.z, v[0][j].w * rs0 * g.w};
                const float yb[4] = {v[1][j].x * rs1 * g.x, v[1][j].y * rs1 * g.y, v[1][j].z * rs1 * g.z, v[1][j].w * rs1 * g.w};
                uint2 w; w.x = pk_bf16(ya[0], ya[1]); w.y = pk_bf16(ya[2], ya[3]);
                *(uint2*)(h1a + 4 * (lane + 64 * j)) = w;
                w.x = pk_bf16(yb[0], yb[1]); w.y = pk_bf16(yb[2], yb[3]);
                *(uint2*)(h1a + DM + 4 * (lane + 64 * j)) = w;
#pragma unroll
                for (int e = 0; e < 4; ++e) {
                    const float4 g0 = *(const float4*)(sG + ((j * 4 + e) * 64 + lane) * 4), g1 = *(const float4*)(sG + 4096 + ((j * 4 + e) * 64 + lane) * 4);
                    ga[0][0] += ya[e] * g0.x; ga[0][1] += ya[e] * g0.y; ga[0][2] += ya[e] * g0.z; ga[0][3] += ya[e] * g0.w;
                    ga[0][4] += ya[e] * g1.x; ga[0][5] += ya[e] * g1.y; ga[0][6] += ya[e] * g1.z; ga[0][7] += ya[e] * g1.w;
                    ga[1][0] += yb[e] * g0.x; ga[1][1] += yb[e] * g0.y; ga[1][2] += yb[e] * g0.z; ga[1][3] += yb[e] * g0.w;
                    ga[1][4] += yb[e] * g1.x; ga[1][5] += yb[e] * g1.y; ga[1][6] += yb[e] * g1.z; ga[1][7] += yb[e] * g1.w;
                }
                asm volatile("" ::: "memory");
            }
#pragma unroll
            for (int rr = 0; rr < 2; ++rr) {
#pragma unroll
                for (int c = 0; c < 8; ++c) ga[rr][c] = wave_sum(ga[rr][c]);
                if (lane == 0) {
                    float* G = (float*)(p.ws + OFF_GATES) + (size_t)(row0 + rr) * 8;
                    float4 o0, o1;
                    o0.x = ga[rr][0] + p.ig_b[0]; o0.y = ga[rr][1] + p.ig_b[1]; o0.z = ga[rr][2] + p.ig_b[2]; o0.w = ga[rr][3] + p.ig_b[3];
                    o1.x = log_sigmoid(ga[rr][4] + p.fg_b[0]); o1.y = log_sigmoid(ga[rr][5] + p.fg_b[1]); o1.z = log_sigmoid(ga[rr][6] + p.fg_b[2]); o1.w = log_sigmoid(ga[rr][7] + p.fg_b[3]);
                    *(float4*)G = o0; *(float4*)(G + 4) = o1;
                }
            }
        }
    }
    __syncthreads();
}

template <int MODE>
__device__ void gemm_tile(const Params& p, const u16* __restrict__ A, const u16* __restrict__ Bt, const int K, const int m0, const int n0, unsigned char* smem) {
    u16* sA = (u16*)smem;
    u16* sB = sA + 2 * 128 * 72;
    int tid_ = TIDX; asm volatile("" : "+v"(tid_)); const int tid = tid_, lane = tid & 63, wave = __builtin_amdgcn_readfirstlane(tid >> 6), fr = lane & 15, fq = lane >> 4, wm = wave >> 1, wn = wave & 1;
    f32x4 acc[4][4];
#pragma unroll
    for (int i = 0; i < 4; ++i)
#pragma unroll
        for (int j = 0; j < 4; ++j) acc[i][j] = (f32x4){0.f, 0.f, 0.f, 0.f};
    uint4 ra[4], rb[4];
    const int crow = tid >> 3, ccol = (tid & 7) * 8;
    const u16* gA = A + (size_t)(m0 + crow) * K + ccol;
    const u16* gB = Bt + (size_t)(n0 + crow) * K + ccol;
#pragma unroll
    for (int i = 0; i < 4; ++i) { ra[i] = *(const uint4*)(gA + (size_t)(32 * i) * K); rb[i] = *(const uint4*)(gB + (size_t)(32 * i) * K); }
#pragma unroll
    for (int i = 0; i < 4; ++i) { *(uint4*)(sA + (crow + 32 * i) * 72 + ccol) = ra[i]; *(uint4*)(sB + (crow + 32 * i) * 72 + ccol) = rb[i]; }
    __syncthreads();
    const int nk = K >> 6;
    for (int kt = 0; kt < nk; ++kt) {
        if (kt + 1 < nk) {
#pragma unroll
            for (int i = 0; i < 4; ++i) { ra[i] = *(const uint4*)(gA + (size_t)(32 * i) * K + (kt + 1) * 64); rb[i] = *(const uint4*)(gB + (size_t)(32 * i) * K + (kt + 1) * 64); }
        }
        const u16* a = sA + (kt & 1) * 128 * 72;
        const u16* b = sB + (kt & 1) * 128 * 72;
#pragma unroll
        for (int ks = 0; ks < 2; ++ks) {
            bf16x8 af[4], bfr[4];
#pragma unroll
            for (int mi = 0; mi < 4; ++mi) af[mi] = *(const bf16x8*)(a + (wm * 64 + mi * 16 + fr) * 72 + ks * 32 + fq * 8);
#pragma unroll
            for (int ni = 0; ni < 4; ++ni) bfr[ni] = *(const bf16x8*)(b + (wn * 64 + ni * 16 + fr) * 72 + ks * 32 + fq * 8);
#pragma unroll
            for (int mi = 0; mi < 4; ++mi)
#pragma unroll
                for (int ni = 0; ni < 4; ++ni) {
                    if (MODE == 2) acc[mi][ni] = mfma_f16(bfr[ni], af[mi], acc[mi][ni]);
                    else acc[mi][ni] = mfma_bf16(bfr[ni], af[mi], acc[mi][ni]);
                }
        }
        if (kt + 1 < nk) {
            u16* a2 = sA + ((kt + 1) & 1) * 128 * 72;
            u16* b2 = sB + ((kt + 1) & 1) * 128 * 72;
#pragma unroll
            for (int i = 0; i < 4; ++i) { *(uint4*)(a2 + (crow + 32 * i) * 72 + ccol) = ra[i]; *(uint4*)(b2 + (crow + 32 * i) * 72 + ccol) = rb[i]; }
        }
        __syncthreads();
    }
#pragma unroll
    for (int mi = 0; mi < 4; ++mi) {
        const size_t row = (size_t)(m0 + wm * 64 + mi * 16 + fr);
#pragma unroll
        for (int ni = 0; ni < 4; ++ni) {
            const int col = n0 + wn * 64 + ni * 16 + 4 * fq;
            const f32x4 c = acc[mi][ni];
            if (MODE == 0) {
                const int arr = col >> 9, within = col & 511;
                u16* dst = (u16*)(p.ws + OFF_R1 + (size_t)arr * 32 * MIB) + row * 512 + within;
                uint2 w; w.x = pk_bf16(c[0], c[1]); w.y = pk_bf16(c[2], c[3]);
                *(uint2*)dst = w;
            } else if (MODE == 1) {
                const float4 xin = *(const float4*)(p.x + row * DM + col);
                float4 o; o.x = xin.x + c[0]; o.y = xin.y + c[1]; o.z = xin.z + c[2]; o.w = xin.w + c[3];
                *(float4*)((float*)(p.ws + OFF_X1) + row * DM + col) = o;
            } else {
                u16* dst = (u16*)(p.ws + OFF_QP) + row * 2048 + col;
                uint2 w; w.x = pk_f16(c[0], c[1]); w.y = pk_f16(c[2], c[3]);
                *(uint2*)dst = w;
            }
        }
    }
}

__device__ void mlstm_local(const Params& p, const int item, unsigned char* smem) {
    int tid_ = TIDX; asm volatile("" : "+v"(tid_)); const int tid = tid_, lane = tid & 63, wave = __builtin_amdgcn_readfirstlane(tid >> 6), fr = lane & 15, fq = lane >> 4;
    const int b = item >> 8, h = (item >> 6) & 3, n = item & 63;
    const size_t t0 = (size_t)b * SEQ + (size_t)n * 128;
    u16* sC = (u16*)smem;
    u16* sKT = sC + 128 * 136;
    float* sW = (float*)(sKT + 128 * 136);
    const u16* U = (const u16*)(p.ws + OFF_U);
    u16* CH = (u16*)(p.ws + OFF_CH);
    {
        const int cc = tid & 15, rg = tid >> 4, col = h * 128 + cc * 8;
        const int s0 = n * 128 + rg * 8;
        const u16* ub = U + ((size_t)b * SEQ) * 512 + col;
        uint4 ur[11];
#pragma unroll
        for (int j = 0; j < 11; ++j) {
            const int sp = s0 - 3 + j;
            ur[j] = (sp >= 0) ? *(const uint4*)(ub + (size_t)sp * 512) : make_uint4(0, 0, 0, 0);
        }
        float wv[4][8], bv[8];
#pragma unroll
        for (int k = 0; k < 4; ++k) {
            const float4 a = *(const float4*)(p.conv_w + k * 512 + col), c2 = *(const float4*)(p.conv_w + k * 512 + col + 4);
            wv[k][0] = a.x; wv[k][1] = a.y; wv[k][2] = a.z; wv[k][3] = a.w; wv[k][4] = c2.x; wv[k][5] = c2.y; wv[k][6] = c2.z; wv[k][7] = c2.w;
        }
        { const float4 a = *(const float4*)(p.conv_b + col), c2 = *(const float4*)(p.conv_b + col + 4);
          bv[0] = a.x; bv[1] = a.y; bv[2] = a.z; bv[3] = a.w; bv[4] = c2.x; bv[5] = c2.y; bv[6] = c2.z; bv[7] = c2.w; }
        float uf[11][8];
#pragma unroll
        for (int j = 0; j < 11; ++j) unpack8_bf16(ur[j], uf[j]);
#pragma unroll
        for (int r = 0; r < 8; ++r) {
            float cv[8];
#pragma unroll
            for (int e = 0; e < 8; ++e) {
                const float y = wv[0][e] * uf[r][e] + wv[1][e] * uf[r + 1][e] + wv[2][e] * uf[r + 2][e] + wv[3][e] * uf[r + 3][e] + bv[e];
                cv[e] = y * sigmoidf_(y);
            }
            uint4 o; o.x = pk_bf16(cv[0], cv[1]); o.y = pk_bf16(cv[2], cv[3]); o.z = pk_bf16(cv[4], cv[5]); o.w = pk_bf16(cv[6], cv[7]);
            *(uint4*)(sC + (rg * 8 + r) * 136 + cc * 8) = o;
            *(uint4*)(CH + (t0 + rg * 8 + r) * 512 + col) = o;
        }
    }
    if (wave == 0) {
        const float* G = (const float*)(p.ws + OFF_GATES);
        const int l0 = 2 * lane, l1 = l0 + 1;
        const float gi0 = G[(t0 + l0) * 8 + h], gi1 = G[(t0 + l1) * 8 + h];
        const float gf0 = G[(t0 + l0) * 8 + 4 + h], gf1 = G[(t0 + l1) * 8 + 4 + h];
        const float s = gf0 + gf1;
        float incl = s;
#pragma unroll
        for (int o = 1; o < 64; o <<= 1) { const float t = __shfl_up(incl, o); if (lane >= o) incl += t; }
        const float excl = incl - s;
        const float b0 = excl + gf0, b1 = incl;
        const float blast = __shfl(incl, 63);
        const float g0 = blast - b0 + gi0, g1 = blast - b1 + gi1;
        const float m = wave_max(fmaxf(g0, g1));
        sW[l0] = __expf(g0 - m); sW[l1] = __expf(g1 - m);
        float* BC = (float*)(p.ws + OFF_BCUM);
        BC[(t0 + l0) * 4 + h] = b0; BC[(t0 + l1) * 4 + h] = b1;
        if (lane == 0) { ((float*)(p.ws + OFF_MLOC))[item] = m; ((float*)(p.ws + OFF_BLAST))[item] = blast; }
    }
    __syncthreads();
    {
        bf16x8 wq[2][4], wk[2][4];
        const u16* Wq = (const u16*)(p.ws + OFF_WQM) + h * 16384;
        const u16* Wk = (const u16*)(p.ws + OFF_WKM) + h * 16384;
#pragma unroll
        for (int nn = 0; nn < 2; ++nn)
#pragma unroll
            for (int ks = 0; ks < 4; ++ks) {
                wq[nn][ks] = *(const bf16x8*)(Wq + ((wave * 2 + nn) * 16 + fr) * 128 + ks * 32 + fq * 8);
                wk[nn][ks] = *(const bf16x8*)(Wk + ((wave * 2 + nn) * 16 + fr) * 128 + ks * 32 + fq * 8);
            }
        u16* dq = (u16*)(p.ws + OFF_QM);
        u16* dk = (u16*)(p.ws + OFF_KM);
#pragma unroll
        for (int mi = 0; mi < 8; ++mi) {
            bf16x8 af[4];
#pragma unroll
            for (int ks = 0; ks < 4; ++ks) af[ks] = *(const bf16x8*)(sC + (mi * 16 + fr) * 136 + ks * 32 + fq * 8);
            const int row = mi * 16 + fr;
            const float wrow = sW[row];
#pragma unroll
            for (int nn = 0; nn < 2; ++nn) {
                f32x4 aq = (f32x4){0.f, 0.f, 0.f, 0.f}, ak = (f32x4){0.f, 0.f, 0.f, 0.f};
#pragma unroll
                for (int ks = 0; ks < 4; ++ks) { aq = mfma_bf16(wq[nn][ks], af[ks], aq); ak = mfma_bf16(wk[nn][ks], af[ks], ak); }
                const int d = (wave * 2 + nn) * 16 + 4 * fq;
                uint2 w; w.x = pk_bf16(aq[0], aq[1]); w.y = pk_bf16(aq[2], aq[3]);
                *(uint2*)(dq + (t0 + row) * 512 + h * 128 + d) = w;
                w.x = pk_bf16(ak[0], ak[1]); w.y = pk_bf16(ak[2], ak[3]);
                *(uint2*)(dk + (t0 + row) * 512 + h * 128 + d) = w;
                uint2 wkk; wkk.x = pk_bf16(ak[0] * wrow, ak[1] * wrow); wkk.y = pk_bf16(ak[2] * wrow, ak[3] * wrow);
                *(uint2*)(sKT + row * 136 + d) = wkk;
            }
        }
    }
    __syncthreads();
    u16* sVT = sC;
    {
        const u16* VM = (const u16*)(p.ws + OFF_VM);
#pragma unroll
        for (int i = 0; i < 8; ++i) {
            const int c = tid + 256 * i, row = c >> 4, cc = c & 15;
            const uint4 v = *(const uint4*)(VM + (t0 + row) * 512 + h * 128 + cc * 8);
            *(uint4*)(sVT + row * 136 + cc * 8) = v;
        }
    }
    __syncthreads();
    if (tid < 128) {
        float s = 0.f;
#pragma unroll 16
        for (int l = 0; l < 128; ++l) s += bf2f(sKT[l * 136 + tid]);
        ((float*)(p.ws + OFF_NCH))[(size_t)item * 128 + tid] = s;
    }
    {
        f32x4 acc[2][8];
#pragma unroll
        for (int mi = 0; mi < 2; ++mi)
#pragma unroll
            for (int nj = 0; nj < 8; ++nj) acc[mi][nj] = (f32x4){0.f, 0.f, 0.f, 0.f};
#pragma unroll
        for (int ks = 0; ks < 4; ++ks) {
            const int lr = ks * 32 + fq * 8 + (fr >> 2), cs = 4 * (fr & 3);
            const bf16x8 x0 = cat4(ld_tr(sKT + lr * 136 + wave * 32 + cs), ld_tr(sKT + (lr + 4) * 136 + wave * 32 + cs));
            const bf16x8 x1 = cat4(ld_tr(sKT + lr * 136 + wave * 32 + 16 + cs), ld_tr(sKT + (lr + 4) * 136 + wave * 32 + 16 + cs));
#pragma unroll
            for (int nj = 0; nj < 8; ++nj) {
                const bf16x8 y = cat4(ld_tr(sVT + lr * 136 + nj * 16 + cs), ld_tr(sVT + (lr + 4) * 136 + nj * 16 + cs));
                acc[0][nj] = mfma_bf16(x0, y, acc[0][nj]);
                acc[1][nj] = mfma_bf16(x1, y, acc[1][nj]);
            }
        }
        float* CCH = (float*)(p.ws + OFF_CCH) + (size_t)item * 16384;
#pragma unroll
        for (int mi = 0; mi < 2; ++mi)
#pragma unroll
            for (int nj = 0; nj < 8; ++nj) {
                const int kd0 = wave * 32 + mi * 16 + 4 * fq, v = nj * 16 + fr;
                const f32x4 c = acc[mi][nj];
                *(float4*)(CCH + v * 128 + kd0) = make_float4(c[0], c[1], c[2], c[3]);
            }
    }
    __syncthreads();
}

struct AttnItem { int pat, b, h, dl, r, n; };
__device__ __forceinline__ AttnItem attn_decode(const int item) {
    AttnItem a; const int blk = item & 63; a.h = (item >> 6) & 7; a.b = (item >> 9) & 3; a.pat = item >> 11;
    a.dl = 2 * a.pat; const int nb = 64 >> a.dl; a.r = blk >> (6 - a.dl); a.n = blk & (nb - 1); return a;
}
#define ATT_BUF 74368
#define KV_FOR(X) X(0) X(1) X(2) X(3)
#define KV_DECL(i) uint4 kr##i, vr##i;
#define KV_ISSUE(i) { const int c_ = tid + 512 * (i), j_ = c_ >> 3; const int jj_ = (L.n > 0 || j_ >= 128) ? j_ : j_ + 128; \
        const size_t off_ = ((size_t)L.b * SEQ + (size_t)((((L.n - 1) * 128 + jj_) << L.dl) + L.r)) * 512 + L.h * 64 + (c_ & 7) * 8; \
        kr##i = *(const uint4*)(KA + off_); vr##i = *(const uint4*)(VA + off_); }
#define KV_FILL(i) { const int c_ = tid + 512 * (i), j_ = c_ >> 3, cc_ = c_ & 7; const bool valid_ = (F.n > 0) || (j_ >= 128); \
        const uint4 kv_ = valid_ ? kr##i : make_uint4(0, 0, 0, 0), vv_ = valid_ ? vr##i : make_uint4(0, 0, 0, 0); \
        float f_[8]; unpack8_bf16(kv_, f_); float ss_ = 0.f; \
        _Pragma("unroll") for (int e_ = 0; e_ < 8; ++e_) ss_ += f_[e_] * f_[e_]; \
        ss_ += __int_as_float(__builtin_amdgcn_update_dpp(0, __float_as_int(ss_), 0xB1, 0xF, 0xF, true));   \
        ss_ += __int_as_float(__builtin_amdgcn_update_dpp(0, __float_as_int(ss_), 0x4E, 0xF, 0xF, true));   \
        ss_ += __int_as_float(__builtin_amdgcn_update_dpp(0, __float_as_int(ss_), 0x141, 0xF, 0xF, true));   \
        const float rs_ = rsqrtf(ss_ * (1.0f / 64.0f) + 1e-6f); \
        const float4 g0_ = *(const float4*)(sGk + F.h * 64 + cc_ * 8), g1_ = *(const float4*)(sGk + F.h * 64 + cc_ * 8 + 4);   \
        uint4 o_; o_.x = pk_bf16(f_[0] * rs_ * g0_.x, f_[1] * rs_ * g0_.y); o_.y = pk_bf16(f_[2] * rs_ * g0_.z, f_[3] * rs_ * g0_.w); \
        o_.z = pk_bf16(f_[4] * rs_ * g1_.x, f_[5] * rs_ * g1_.y); o_.w = pk_bf16(f_[6] * rs_ * g1_.z, f_[7] * rs_ * g1_.w); \
        *(uint4*)(fK + j_ * 72 + cc_ * 8) = o_; \
        *(uint4*)(fV + j_ * 72 + cc_ * 8) = vv_; }
#define Q_ISSUE(A, B) { const int i_ = wave * 16 + fr; const u16* qrow_ = QA + ((size_t)L.b * SEQ + (size_t)((((L.n * 128) + i_) << L.dl) + L.r)) * 512 + L.h * 64; \
        A = *(const uint4*)(qrow_ + fq * 8); B = *(const uint4*)(qrow_ + 32 + fq * 8); }
#define ATT_FILLBUF(bufp, ITEM) { const AttnItem F = (ITEM); u16* fK = (u16*)(bufp); u16* fV = fK + 256 * 72; float* fB = (float*)(fV + 256 * 72); \
        if (tid < 160) fB[tid] = (tid >= 16 && tid <= 144) ? sRB[(int)sCB[F.pat * 132 + tid - 16] * 8 + F.h] : -INFINITY;   \
        KV_FOR(KV_FILL) }

__device__ void attn_phase(const Params& p, unsigned char* smem_all) {
    int tid_ = threadIdx.x; asm volatile("" : "+v"(tid_)); const int tid = tid_, lane = tid & 63, wave = __builtin_amdgcn_readfirstlane(tid >> 6), fr = lane & 15, fq = lane >> 4;
    const int G = gridDim.x;
    int item = blockIdx.x;
    if (item >= 6144) return;
    const u16* QA = (const u16*)(p.ws + OFF_QA);
    const u16* KA = (const u16*)(p.ws + OFF_KA);
    const u16* VA = (const u16*)(p.ws + OFF_VA);
    float* sGq = (float*)(smem_all + 2 * ATT_BUF); float* sGk = sGq + 512;
    float* sRB = sGk + 512; unsigned char* sCB = (unsigned char*)(sRB + 256);
    sGq[tid] = p.qn_g[tid]; sGk[tid] = p.kn_g[tid];
    if (tid < 256) sRB[tid] = p.rel_bias[tid] * 1.4426950408889634f;
    if (tid < 396) sCB[tid] = c_bucket[tid / 132][tid % 132];
    __syncthreads();
    KV_FOR(KV_DECL)
    uint4 q0, q1, nq0, nq1;
    AttnItem C = attn_decode(item);
    { const AttnItem L = C; KV_FOR(KV_ISSUE) Q_ISSUE(q0, q1) }
    ATT_FILLBUF(smem_all, C)
    int par = 0;
    AttnItem N = attn_decode((item + G < 6144) ? item + G : item);
    { const AttnItem L = N; KV_FOR(KV_ISSUE) Q_ISSUE(nq0, nq1) }
    __syncthreads();
    for (;;) {
        const int itn = item + G;
        const bool has_next = itn < 6144;
        AttnItem N2 = N;
        uint4 nn0, nn1;
        const u16* sK = (const u16*)(smem_all + par * ATT_BUF);
        const u16* sVT = sK + 256 * 72;
        const float* sBias = (const float*)(sVT + 256 * 72);
        const int n = C.n, h = C.h, dl = C.dl, r = C.r;
        const size_t tb = (size_t)C.b * SEQ;
        const float* sBl = sBias + (16 + 128 - 131 + fr - 4 * fq);
        u16* ATTO = (u16*)(p.ws + OFF_ATTO) + (size_t)C.pat * T_TOK * 512;
        float* LSE = (float*)(p.ws + OFF_LSE) + (size_t)C.pat * T_TOK * 8;
        {
            const int qb = wave;
            const int i = qb * 16 + fr;
            const size_t posq = tb + (size_t)((((n * 128) + i) << dl) + r);
            bf16x8 qf[2];
            {
                float f0[8], f1[8];
                unpack8_bf16(q0, f0); unpack8_bf16(q1, f1);
                float ss = 0.f;
#pragma unroll
                for (int e = 0; e < 8; ++e) ss += f0[e] * f0[e] + f1[e] * f1[e];
                ss += __shfl_xor(ss, 16); ss += __shfl_xor(ss, 32);
                const float rs = rsqrtf(ss * (1.0f / 64.0f) + 1e-6f) * (0.125f * 1.4426950408889634f);
                const float* g = sGq + h * 64 + fq * 8;
                uint4 o0, o1;
                o0.x = pk_bf16(f0[0] * rs * g[0], f0[1] * rs * g[1]); o0.y = pk_bf16(f0[2] * rs * g[2], f0[3] * rs * g[3]);
                o0.z = pk_bf16(f0[4] * rs * g[4], f0[5] * rs * g[5]); o0.w = pk_bf16(f0[6] * rs * g[6], f0[7] * rs * g[7]);
                o1.x = pk_bf16(f1[0] * rs * g[32], f1[1] * rs * g[33]); o1.y = pk_bf16(f1[2] * rs * g[34], f1[3] * rs * g[35]);
                o1.z = pk_bf16(f1[4] * rs * g[36], f1[5] * rs * g[37]); o1.w = pk_bf16(f1[6] * rs * g[38], f1[7] * rs * g[39]);
                qf[0] = __builtin_bit_cast(bf16x8, o0); qf[1] = __builtin_bit_cast(bf16x8, o1);
            }
            f32x4 s[10];
            {
                bf16x8 kf[9][2];
#pragma unroll
                for (int kk = 0; kk < 9; ++kk)
#pragma unroll
                    for (int ks = 0; ks < 2; ++ks) kf[kk][ks] = *(const bf16x8*)(sK + ((qb + kk) * 16 + fr) * 72 + ks * 32 + fq * 8);
#pragma unroll
                for (int kk = 0; kk < 9; ++kk) s[kk] = mfma_bf16(kf[kk][0], qf[0], (f32x4){0.f, 0.f, 0.f, 0.f});
#pragma unroll
                for (int kk = 0; kk < 9; ++kk) s[kk] = mfma_bf16(kf[kk][1], qf[1], s[kk]);
            }
            s[9] = (f32x4){0.f, 0.f, 0.f, 0.f};
            if (has_next) {
                ATT_FILLBUF(smem_all + (par ^ 1) * ATT_BUF, N)
                N2 = attn_decode((itn + G < 6144) ? itn + G : itn);
            }
            { const AttnItem L = N2; KV_FOR(KV_ISSUE) Q_ISSUE(nn0, nn1) }
            float bb[36];
#pragma unroll
            for (int kk = 0; kk < 9; ++kk)
#pragma unroll
                for (int rr = 0; rr < 4; ++rr) bb[kk * 4 + rr] = sBl[131 - 16 * kk - rr];
            const float mx = 0.f;
            float sum = 0.f;
            if (n > 0) {
#pragma unroll
                for (int kk = 0; kk < 9; ++kk)
#pragma unroll
                    for (int rr = 0; rr < 4; ++rr) {
                        const float e = __builtin_amdgcn_exp2f(s[kk][rr] + bb[kk * 4 + rr]);
                        s[kk][rr] = e; sum += e;
                    }
            } else {
#pragma unroll
                for (int kk = 0; kk < 9; ++kk)
#pragma unroll
                    for (int rr = 0; rr < 4; ++rr) {
                        const int j = (qb + kk) * 16 + 4 * fq + rr;
                        const float e = (j >= 128) ? __builtin_amdgcn_exp2f(s[kk][rr] + bb[kk * 4 + rr]) : 0.f;
                        s[kk][rr] = e; sum += e;
                    }
            }
            sum += __shfl_xor(sum, 16); sum += __shfl_xor(sum, 32);
            bf16x8 pf[5];
#pragma unroll
            for (int kp = 0; kp < 5; ++kp) {
                uint4 o;
                o.x = pk_bf16(s[2 * kp][0], s[2 * kp][1]); o.y = pk_bf16(s[2 * kp][2], s[2 * kp][3]);
                o.z = pk_bf16(s[2 * kp + 1][0], s[2 * kp + 1][1]); o.w = pk_bf16(s[2 * kp + 1][2], s[2 * kp + 1][3]);
                pf[kp] = __builtin_bit_cast(bf16x8, o);
            }
            const float inv = __builtin_amdgcn_rcpf(sum);
            unsigned ow[8];
#pragma unroll
            for (int vp = 0; vp < 2; ++vp) {
                s16x4 lo[2][5], hi[2][5];
#pragma unroll
                for (int v = 0; v < 2; ++v)
#pragma unroll
                    for (int kp = 0; kp < 5; ++kp) {
                        const int vb = 2 * vp + v, kbA = qb + 2 * kp, kbB = (kbA + 1 > 15) ? kbA : kbA + 1;
                        lo[v][kp] = ld_tr(sVT + (kbA * 16 + 4 * fq + (fr >> 2)) * 72 + 16 * (fr & 3) + 4 * vb);
                        hi[v][kp] = ld_tr(sVT + (kbB * 16 + 4 * fq + (fr >> 2)) * 72 + 16 * (fr & 3) + 4 * vb);
                    }
                f32x4 acc[2] = {(f32x4){0.f, 0.f, 0.f, 0.f}, (f32x4){0.f, 0.f, 0.f, 0.f}};
#pragma unroll
                for (int kp = 0; kp < 5; ++kp)
#pragma unroll
                    for (int v = 0; v < 2; ++v) acc[v] = mfma_bf16(cat4(lo[v][kp], hi[v][kp]), pf[kp], acc[v]);
#pragma unroll
                for (int v = 0; v < 2; ++v) { ow[2 * (2 * vp + v)] = pk_bf16(acc[v][0] * inv, acc[v][1] * inv); ow[2 * (2 * vp + v) + 1] = pk_bf16(acc[v][2] * inv, acc[v][3] * inv); }
            }
            {
                u16* orow = ATTO + posq * 512 + h * 64 + 16 * fq;
                *(uint4*)orow = make_uint4(ow[0], ow[1], ow[2], ow[3]);
                *(uint4*)(orow + 8) = make_uint4(ow[4], ow[5], ow[6], ow[7]);
            }
            if (fq == 0) LSE[posq * 8 + h] = mx + __logf(sum);
        }
        __syncthreads();
        if (!has_next) break;
        item = itn; C = N; N = N2; q0 = nq0; q1 = nq1; nq0 = nn0; nq1 = nn1; par ^= 1;
    }
}

#define P3_ITEMS 528
__device__ void scan_item(const Params& p, const int item) {
    const int tid = TIDX;
    const float* BL = (const float*)(p.ws + OFF_BLAST);
    const float* ML = (const float*)(p.ws + OFF_MLOC);
    if (item < 512) {
        const int bh = item >> 5;
        const size_t e0 = (size_t)(item & 31) * 512 + tid * 2;
        const float* CCH = (const float*)(p.ws + OFF_CCH);
        u16* CP = (u16*)(p.ws + OFF_CPREV);
        float c0 = 0.f, c1 = 0.f, m = 0.f;
#pragma unroll 1
        for (int nh = 0; nh < 64; nh += 16) {
        float2 ccv[16];
#pragma unroll
        for (int n = 0; n < 16; ++n) ccv[n] = *(const float2*)(CCH + (size_t)(bh * 64 + nh + n) * 16384 + e0);
#pragma unroll
        for (int nn = 0; nn < 16; ++nn) {
            const int n = nh + nn;
            const int it = bh * 64 + n;
            const float bl = BL[it], ml = ML[it];
            const float2 cc = ccv[nn];
            *(unsigned*)(CP + (size_t)it * 16384 + e0) = pk_bf16(c0, c1);
            const float mn = fmaxf(bl + m, ml);
            const float a = __expf(bl + m - mn), bb = __expf(ml - mn);
            c0 = a * c0 + bb * cc.x; c1 = a * c1 + bb * cc.y; m = mn;
        }
        }
    } else {
        const int bh = item - 512;
        if (tid < 128) {
            const float* NCH = (const float*)(p.ws + OFF_NCH);
            float* NP = (float*)(p.ws + OFF_NPREV);
            float* MP = (float*)(p.ws + OFF_MPREV);
            float nv = 0.f, m = 0.f;
#pragma unroll 1
            for (int nh = 0; nh < 64; nh += 16) {
            float ccv[16], blv[16], mlv[16];
#pragma unroll
            for (int n = 0; n < 16; ++n) { ccv[n] = NCH[(size_t)(bh * 64 + nh + n) * 128 + tid]; blv[n] = BL[bh * 64 + nh + n]; mlv[n] = ML[bh * 64 + nh + n]; }
#pragma unroll
            for (int nn = 0; nn < 16; ++nn) {
                const int n = nh + nn;
                const int it = bh * 64 + n;
                const float bl = blv[nn], ml = mlv[nn];
                const float cc = ccv[nn];
                NP[(size_t)it * 128 + tid] = nv;
                if (tid == 0) MP[it] = m;
                const float mn = fmaxf(bl + m, ml);
                const float a = __expf(bl + m - mn), bb = __expf(ml - mn);
                nv = a * nv + bb * cc; m = mn;
            }
            }
        }
    }
}

__device__ void mlstm_out(const Params& p, const int item, unsigned char* smem) {
    int tid_ = TIDX; asm volatile("" : "+v"(tid_)); const int tid = tid_, lane = tid & 63, wave = __builtin_amdgcn_readfirstlane(tid >> 6), fr = lane & 15, fq = lane >> 4;
    const int b = item >> 8, h = (item >> 6) & 3, n = item & 63;
    const size_t t0 = (size_t)b * SEQ + (size_t)n * 128;
    u16* sK = (u16*)smem;
    u16* sVT = sK + 128 * 136;
    float* sAj = (float*)(sVT + 128 * 136);
    float* sMi = sAj + 128;
    float* sBi = sMi + 128;
    float* sNp = sBi + 128;
    const u16* KM = (const u16*)(p.ws + OFF_KM);
    const u16* VM = (const u16*)(p.ws + OFF_VM);
    const u16* QM = (const u16*)(p.ws + OFF_QM);
    const u16* CP = (const u16*)(p.ws + OFF_CPREV) + (size_t)item * 16384;
    const float mprev = ((const float*)(p.ws + OFF_MPREV))[item];
    uint4 kr[8], vr[8];
#define CR_FOR(X) X(0) X(1) X(2) X(3) X(4) X(5) X(6) X(7)
#define CR_DECL(i) uint4 cr##i;
#define CR_LOAD(i) { const int c_ = tid + 256 * (i); cr##i = *(const uint4*)(CP + (c_ >> 4) * 128 + (c_ & 15) * 8); }
#define CR_STORE(i) { const int c_ = tid + 256 * (i); *(uint4*)(sK + (c_ >> 4) * 136 + (c_ & 15) * 8) = cr##i; }
    CR_FOR(CR_DECL)
#pragma unroll
    for (int i = 0; i < 8; ++i) {
        const int c = tid + 256 * i, row = c >> 4, cc = c & 15;
        kr[i] = *(const uint4*)(KM + (t0 + row) * 512 + h * 128 + cc * 8);
        vr[i] = *(const uint4*)(VM + (t0 + row) * 512 + h * 128 + cc * 8);
    }
    CR_FOR(CR_LOAD)
    bf16x8 qf[2][4];
#pragma unroll
    for (int qbl = 0; qbl < 2; ++qbl) {
        const u16* qrow = QM + (t0 + (wave * 2 + qbl) * 16 + fr) * 512 + h * 128;
#pragma unroll
        for (int ks = 0; ks < 4; ++ks) qf[qbl][ks] = *(const bf16x8*)(qrow + ks * 32 + fq * 8);
    }
#pragma unroll
    for (int i = 0; i < 8; ++i) {
        const int c = tid + 256 * i, row = c >> 4, cc = c & 15;
        *(uint4*)(sK + row * 136 + cc * 8) = kr[i];
        *(uint4*)(sVT + row * 136 + cc * 8) = vr[i];
    }
    if (wave == 0) {
        const float* G = (const float*)(p.ws + OFF_GATES);
        const float* BC = (const float*)(p.ws + OFF_BCUM);
        const int l0 = 2 * lane, l1 = l0 + 1;
        const float b0 = BC[(t0 + l0) * 4 + h], b1 = BC[(t0 + l1) * 4 + h];
        const float a0 = G[(t0 + l0) * 8 + h] - b0, a1 = G[(t0 + l1) * 8 + h] - b1;
        const float pm = fmaxf(a0, a1);
        float incl = pm;
#pragma unroll
        for (int o = 1; o < 64; o <<= 1) { const float t = __shfl_up(incl, o); if (lane >= o) incl = fmaxf(incl, t); }
        float excl = __shfl_up(incl, 1);
        if (lane == 0) excl = -INFINITY;
        sAj[l0] = a0; sAj[l1] = a1;
        sMi[l0] = fmaxf(mprev, fmaxf(excl, a0)); sMi[l1] = fmaxf(mprev, incl);
        sBi[l0] = b0; sBi[l1] = b1;
    } else if (wave == 1) {
        const float* NP = (const float*)(p.ws + OFF_NPREV) + (size_t)item * 128;
        sNp[lane] = NP[lane]; sNp[lane + 64] = NP[lane + 64];
    }
    __syncthreads();
    f32x4 acc[2][8];
    float rowsum[2], qn[2], Mq[2];
#pragma unroll
    for (int qbl = 0; qbl < 2; ++qbl) {
        const int qb = wave * 2 + qbl;
        const int i = qb * 16 + fr;
        const float Mi = sMi[i];
        Mq[qbl] = Mi;
        float qnv = 0.f;
#pragma unroll
        for (int ks = 0; ks < 4; ++ks)
#pragma unroll
            for (int e = 0; e < 8; ++e) qnv += bf2f((u16)qf[qbl][ks][e]) * sNp[ks * 32 + fq * 8 + e];
        qnv += __shfl_xor(qnv, 16); qnv += __shfl_xor(qnv, 32);
        qn[qbl] = qnv;
#pragma unroll
        for (int vb = 0; vb < 8; ++vb) acc[qbl][vb] = (f32x4){0.f, 0.f, 0.f, 0.f};
        float rs_ = 0.f;
#pragma unroll
        for (int kp = 0; kp < 4; ++kp) {
            if (2 * kp <= qb) {
                f32x4 s0 = (f32x4){0.f, 0.f, 0.f, 0.f}, s1 = (f32x4){0.f, 0.f, 0.f, 0.f};
#pragma unroll
                for (int ks = 0; ks < 4; ++ks) {
                    const bf16x8 kf = *(const bf16x8*)(sK + ((2 * kp) * 16 + fr) * 136 + ks * 32 + fq * 8);
                    s0 = mfma_bf16(kf, qf[qbl][ks], s0);
                }
                if (2 * kp + 1 <= qb) {
#pragma unroll
                    for (int ks = 0; ks < 4; ++ks) {
                        const bf16x8 kf = *(const bf16x8*)(sK + ((2 * kp + 1) * 16 + fr) * 136 + ks * 32 + fq * 8);
                        s1 = mfma_bf16(kf, qf[qbl][ks], s1);
                    }
                }
#pragma unroll
                for (int rr = 0; rr < 4; ++rr) {
                    const int j0 = (2 * kp) * 16 + 4 * fq + rr, j1 = j0 + 16;
                    const float d0 = (j0 <= i) ? __expf(sAj[j0] - Mi) : 0.f;
                    const float d1 = (j1 <= i) ? __expf(sAj[j1] - Mi) : 0.f;
                    s0[rr] *= d0; s1[rr] *= d1;
                    rs_ += s0[rr] + s1[rr];
                }
                uint4 o;
                o.x = pk_bf16(s0[0], s0[1]); o.y = pk_bf16(s0[2], s0[3]);
                o.z = pk_bf16(s1[0], s1[1]); o.w = pk_bf16(s1[2], s1[3]);
                const bf16x8 pf = __builtin_bit_cast(bf16x8, o);
#pragma unroll
                for (int vb = 0; vb < 8; ++vb) {
                    const s16x4 lo = ld_tr(sVT + ((2 * kp) * 16 + 4 * fq + (fr >> 2)) * 136 + vb * 16 + 4 * (fr & 3));
                    const s16x4 hi = ld_tr(sVT + ((2 * kp + 1) * 16 + 4 * fq + (fr >> 2)) * 136 + vb * 16 + 4 * (fr & 3));
                    acc[qbl][vb] = mfma_bf16(cat4(lo, hi), pf, acc[qbl][vb]);
                }
            }
            asm volatile("" ::: "memory");
        }
        rs_ += __shfl_xor(rs_, 16); rs_ += __shfl_xor(rs_, 32);
        rowsum[qbl] = rs_;
    }
    __syncthreads();
    CR_FOR(CR_STORE)
    __syncthreads();
    const u16* CH = (const u16*)(p.ws + OFF_CH);
    const u16* Z = (const u16*)(p.ws + OFF_Z);
    u16* Y = (u16*)(p.ws + OFF_Y);
#pragma unroll
    for (int qbl = 0; qbl < 2; ++qbl) {
        const int qb = wave * 2 + qbl;
        const int i = qb * 16 + fr;
        uint2 chv[8], zv[8];
#pragma unroll
        for (int vb = 0; vb < 8; ++vb) {
            const int v = h * 128 + vb * 16 + 4 * fq;
            chv[vb] = *(const uint2*)(CH + (t0 + i) * 512 + v); zv[vb] = *(const uint2*)(Z + (t0 + i) * 512 + v);
        }
        const float Mi = Mq[qbl];
        const float iw = __expf(mprev - Mi);
#pragma unroll
        for (int vb = 0; vb < 8; ++vb) {
            f32x4 a = (f32x4){0.f, 0.f, 0.f, 0.f};
#pragma unroll
            for (int ks = 0; ks < 4; ++ks) {
                const bf16x8 cf = *(const bf16x8*)(sK + (vb * 16 + fr) * 136 + ks * 32 + fq * 8);
                a = mfma_bf16(cf, qf[qbl][ks], a);
            }
            acc[qbl][vb] = acc[qbl][vb] + a * iw;
        }
        const float den = rowsum[qbl] + iw * qn[qbl];
        const float mt = sBi[i] + Mi;
        const float inv = 1.0f / fmaxf(fabsf(den), __expf(-mt));
        float ss = 0.f;
#pragma unroll
        for (int vb = 0; vb < 8; ++vb) { acc[qbl][vb] = acc[qbl][vb] * inv; ss += acc[qbl][vb][0] * acc[qbl][vb][0] + acc[qbl][vb][1] * acc[qbl][vb][1] + acc[qbl][vb][2] * acc[qbl][vb][2] + acc[qbl][vb][3] * acc[qbl][vb][3]; }
        ss += __shfl_xor(ss, 16); ss += __shfl_xor(ss, 32);
        const float rs = rsqrtf(ss * (1.0f / 128.0f) + 1e-6f);
#pragma unroll
        for (int vb = 0; vb < 8; ++vb) {
            const int v = h * 128 + vb * 16 + 4 * fq;
            const float4 g = *(const float4*)(p.mh_norm_g + v), sk = *(const float4*)(p.skip_m + v);
            const float c0 = __uint_as_float(chv[vb].x << 16), c1 = __uint_as_float(chv[vb].x & 0xffff0000u), c2 = __uint_as_float(chv[vb].y << 16), c3 = __uint_as_float(chv[vb].y & 0xffff0000u);
            const float z0 = __uint_as_float(zv[vb].x << 16), z1 = __uint_as_float(zv[vb].x & 0xffff0000u), z2 = __uint_as_float(zv[vb].y << 16), z3 = __uint_as_float(zv[vb].y & 0xffff0000u);
            const float y0 = sigmoidf_(z0) * (acc[qbl][vb][0] * rs * g.x + sk.x * c0);
            const float y1 = sigmoidf_(z1) * (acc[qbl][vb][1] * rs * g.y + sk.y * c1);
            const float y2 = sigmoidf_(z2) * (acc[qbl][vb][2] * rs * g.z + sk.z * c2);
            const float y3 = sigmoidf_(z3) * (acc[qbl][vb][3] * rs * g.w + sk.w * c3);
            uint2 w; w.x = pk_bf16(y0, y1); w.y = pk_bf16(y2, y3);
            *(uint2*)(Y + (t0 + i) * 1024 + v) = w;
        }
        asm volatile("" ::: "memory");
    }
    __syncthreads();
}

__device__ void attn_combine4(const Params& p, const int item0, const int istride) {
    const float* LSE = (const float*)(p.ws + OFF_LSE);
    const u16* AO = (const u16*)(p.ws + OFF_ATTO);
    uint4 a0[4], a1[4], a2[4]; float l0[4], l1[4], l2[4]; size_t tt[4]; int hh[4], cc[4];
#pragma unroll
    for (int q = 0; q < 4; ++q) {
        const size_t idx = (size_t)(item0 + q * istride) * 256 + TIDX;
        const size_t t = idx >> 6; const int h = (int)(idx >> 3) & 7, c8 = (int)idx & 7;
        tt[q] = t; hh[q] = h; cc[q] = c8;
        l0[q] = LSE[t * 8 + h]; l1[q] = LSE[(size_t)T_TOK * 8 + t * 8 + h]; l2[q] = LSE[(size_t)2 * T_TOK * 8 + t * 8 + h];
        const size_t off = t * 512 + h * 64 + c8 * 8;
        a0[q] = *(const uint4*)(AO + off); a1[q] = *(const uint4*)(AO + (size_t)T_TOK * 512 + off); a2[q] = *(const uint4*)(AO + (size_t)2 * T_TOK * 512 + off);
    }
#pragma unroll
    for (int q = 0; q < 4; ++q) {
        const float mx = fmaxf(l0[q], fmaxf(l1[q], l2[q]));
        const float e0 = __expf(l0[q] - mx), e1 = __expf(l1[q] - mx), e2 = __expf(l2[q] - mx);
        const float inv = __builtin_amdgcn_rcpf(e0 + e1 + e2);
        float f0[8], f1[8], f2[8];
        unpack8_bf16(a0[q], f0); unpack8_bf16(a1[q], f1); unpack8_bf16(a2[q], f2);
        float o[8];
#pragma unroll
        for (int e = 0; e < 8; ++e) o[e] = (e0 * f0[e] + e1 * f1[e] + e2 * f2[e]) * inv;
        uint4 w; w.x = pk_bf16(o[0], o[1]); w.y = pk_bf16(o[2], o[3]); w.z = pk_bf16(o[4], o[5]); w.w = pk_bf16(o[6], o[7]);
        *(uint4*)((u16*)(p.ws + OFF_Y) + tt[q] * 1024 + 512 + hh[q] * 64 + cc[q] * 8) = w;
    }
}

#define P6_ROWITEMS (T_TOK / 16)
#define P6_ITEMS (P6_ROWITEMS + 4096)
__device__ void phase6_item(const Params& p, const int item) {
    int tid_ = TIDX; asm volatile("" : "+v"(tid_)); const int tid = tid_, lane = tid & 63, wave = __builtin_amdgcn_readfirstlane(tid >> 6);
    if (item < P6_ROWITEMS) {
        const int row0 = item * 16 + wave * 4;
        float4 v[4][4];
        float ss[4] = {0.f, 0.f, 0.f, 0.f};
#pragma unroll
        for (int rr = 0; rr < 4; ++rr) {
            const float4* xr = (const float4*)((const float*)(p.ws + OFF_X1) + (size_t)(row0 + rr) * DM);
#pragma unroll
            for (int j = 0; j < 4; ++j) v[rr][j] = xr[lane + 64 * j];
        }
#pragma unroll
        for (int rr = 0; rr < 4; ++rr) {
#pragma unroll
            for (int j = 0; j < 4; ++j) ss[rr] += v[rr][j].x * v[rr][j].x + v[rr][j].y * v[rr][j].y + v[rr][j].z * v[rr][j].z + v[rr][j].w * v[rr][j].w;
            ss[rr] = wave_sum(ss[rr]);
        }
#pragma unroll
        for (int rr = 0; rr < 4; ++rr) {
            const int row = row0 + rr;
            const float rs = rsqrtf(ss[rr] * (1.0f / 1024.0f) + 1e-6f);
            u16* h2 = (u16*)(p.ws + OFF_H2) + (size_t)row * DM;
#pragma unroll
            for (int j = 0; j < 4; ++j) {
                const float4 g = ((const float4*)p.norm2_g)[lane + 64 * j];
                const float y0 = v[rr][j].x * rs * g.x, y1 = v[rr][j].y * rs * g.y, y2 = v[rr][j].z * rs * g.z, y3 = v[rr][j].w * rs * g.w;
                uint2 w; w.x = pk_bf16(y0, y1); w.y = pk_bf16(y2, y3);
                *(uint2*)(h2 + 4 * (lane + 64 * j)) = w;
                *(unsigned*)(p.ws + OFF_H2Q + (size_t)row * DM + 4 * (lane + 64 * j)) = pk4_fp8(y0 * 16.f, y1 * 16.f, y2 * 16.f, y3 * 16.f);
            }
        }
    } else {
        const int it = item - P6_ROWITEMS;
        {
            const int which = it >> 10;
            const float* srct = which ? p.expert_v : p.expert_u;
            unsigned char* dstt = p.ws + (which ? OFF_EV4 : OFF_EU4);
            float* sct = (float*)(p.ws + (which ? OFF_SV : OFF_SU));
            const int row0 = (it & 1023) * 16 + wave * 4;
            float4 v[4][4];
#pragma unroll
            for (int rr = 0; rr < 4; ++rr)
#pragma unroll
                for (int j = 0; j < 4; ++j) v[rr][j] = ((const float4*)(srct + (size_t)(row0 + rr) * DM))[lane + 64 * j];
#pragma unroll
            for (int rr = 0; rr < 4; ++rr) {
                const int row = row0 + rr;
                float am = 0.f;
#pragma unroll
                for (int j = 0; j < 4; ++j) am = fmaxf(am, fmaxf(fmaxf(fabsf(v[rr][j].x), fabsf(v[rr][j].y)), fmaxf(fabsf(v[rr][j].z), fabsf(v[rr][j].w))));
                am = wave_max(am);
                const float inv = am > 0.f ? 6.0f / am : 0.f;
                if (lane == 0) sct[row] = am * (1.0f / 6.0f);
#pragma unroll
                for (int j = 0; j < 4; ++j) {
                    unsigned q = 0;
                    q = __builtin_amdgcn_cvt_scalef32_pk_fp4_f32(q, v[rr][j].x * inv, v[rr][j].y * inv, 1.0f, 0);
                    q = __builtin_amdgcn_cvt_scalef32_pk_fp4_f32(q, v[rr][j].z * inv, v[rr][j].w * inv, 1.0f, 1);
                    *(u16*)(dstt + (size_t)row * 512 + (((j + row) & 3) << 7) + 2 * lane) = (u16)(q & 0xffffu);
                }
            }
        }
    }
}

#define INSERT16(top, x)                                                    \
    do {                                                                    \
        if ((x) > top[15]) {                                                \
            _Pragma("unroll") for (int _i = 15; _i >= 1; --_i) top[_i] = __builtin_amdgcn_fmed3f(top[_i - 1], (x), top[_i]); \
            top[0] = fmaxf(top[0], (x));                                    \
        }                                                                   \
    } while (0)

#define CE_DESC(a, b) do { const float _hi = fmaxf(a, b), _lo = fminf(a, b); a = _hi; b = _lo; } while (0)
#define BITONIC_SORT16_DESC(v)                                                                                   \
    do {                                                                                                         \
        _Pragma("unroll") for (int _k = 2; _k <= 16; _k <<= 1)                                                   \
            _Pragma("unroll") for (int _j = _k >> 1; _j > 0; _j >>= 1)                                           \
                _Pragma("unroll") for (int _i = 0; _i < 16; ++_i) {                                              \
                    const int _l = _i ^ _j;                                                                      \
                    if (_l > _i) { if ((_i & _k) == 0) CE_DESC(v[_i], v[_l]); else CE_DESC(v[_l], v[_i]); }      \
                }                                                                                                \
    } while (0)
#define MERGE16_XOR(top, XOR)                                                                                   \
    do {                                                                                                        \
        _Pragma("unroll") for (int _i = 0; _i < 8; ++_i) {                                                      \
            const float _o0 = __shfl_xor(top[15 - _i], XOR), _o1 = __shfl_xor(top[_i], XOR);                    \
            const float _c0 = fmaxf(top[_i], _o0), _c1 = fmaxf(top[15 - _i], _o1);                              \
            top[_i] = _c0; top[15 - _i] = _c1;                                                                  \
        }                                                                                                       \
        _Pragma("unroll") for (int _s = 8; _s >= 1; _s >>= 1)                                                   \
            _Pragma("unroll") for (int _i = 0; _i < 16; ++_i) if ((_i & _s) == 0) CE_DESC(top[_i], top[_i + _s]); \
    } while (0)

__device__ void peer_score_stage(const Params& p, const int h, unsigned char* smem) {
    const int tid = TIDX;
#pragma unroll
    for (int i = 0; i < 16; ++i) {
        const int c = tid + 256 * i, half = c >> 11, key = (c >> 4) & 127, ch = c & 15;
        const uint4 v = *(const uint4*)((const u16*)(p.ws + (half ? OFF_SK2 : OFF_SK1)) + h * 16384 + key * 128 + ch * 8);
        *(uint4*)(smem + half * 32768 + key * 256 + ((ch ^ (key & 15)) << 4)) = v;
    }
    __syncthreads();
}
__device__ void peer_score(const Params& p, const int item, unsigned char* smem) {
    int tid_ = TIDX; asm volatile("" : "+v"(tid_)); const int tid = tid_, lane = tid & 63, wave = __builtin_amdgcn_readfirstlane(tid >> 6), fr = lane & 15, fq = lane >> 4;
    const int tile = item >> 3, h = item & 7;
    const size_t tok = (size_t)tile * 64 + wave * 16 + fr;
    float* sL = (float*)(smem + 65536) + wave * (16 * 48);
    float vtop[2][16];
    bf16x8 yfa[2][4];
#pragma unroll
    for (int half = 0; half < 2; ++half) {
        const u16* qrow = (const u16*)(p.ws + OFF_QP) + tok * 2048 + h * 256 + half * 128;
#pragma unroll
        for (int ks = 0; ks < 4; ++ks) yfa[half][ks] = *(const bf16x8*)(qrow + ks * 32 + fq * 8);
    }
#pragma unroll
    for (int half = 0; half < 2; ++half) {
        const unsigned char* SKl = smem + half * 32768;
        bf16x8 yf[4];
#pragma unroll
        for (int ks = 0; ks < 4; ++ks) yf[ks] = yfa[half][ks];
        float top[16], sec[16];
#pragma unroll
        for (int kb = 0; kb < 8; ++kb) {
            f32x4 a = (f32x4){0.f, 0.f, 0.f, 0.f};
#pragma unroll
            for (int ks = 0; ks < 4; ++ks) {
                const bf16x8 xf = *(const bf16x8*)(SKl + (kb * 16 + fr) * 256 + (((ks * 4 + fq) ^ fr) << 4));
                a = mfma_f16(xf, yf[ks], a);
            }
#pragma unroll
            for (int rr = 0; rr < 4; ++rr) {
                const float x = __uint_as_float((__float_as_uint(a[rr]) & ~0x7Fu) | (unsigned)(kb * 16 + 4 * fq + rr));
                if (kb < 4) top[kb * 4 + rr] = x; else sec[(kb - 4) * 4 + rr] = x;
            }
        }
        BITONIC_SORT16_DESC(top);
        BITONIC_SORT16_DESC(sec);
#pragma unroll
        for (int i = 0; i < 16; ++i) top[i] = fmaxf(top[i], sec[15 - i]);
#pragma unroll
        for (int st = 8; st >= 1; st >>= 1)
#pragma unroll
            for (int i = 0; i < 16; ++i) if ((i & st) == 0) CE_DESC(top[i], top[i + st]);
        MERGE16_XOR(top, 16);
        MERGE16_XOR(top, 32);
#pragma unroll
        for (int i = 0; i < 16; ++i) vtop[half][i] = top[i];
    }
    float best[16];
#pragma unroll
    for (int i = 0; i < 16; ++i) best[i] = -INFINITY;
    {
        float cx[52];
        int nc = 0;
#pragma unroll
        for (int a = 0; a < 16; ++a)
#pragma unroll
            for (int bb = 0; bb < 16; ++bb)
                if ((a + 1) * (bb + 1) <= 16) {
                    const float sm = vtop[0][a] + vtop[1][bb];
                    cx[nc++] = __uint_as_float((__float_as_uint(sm) & ~0xFFu) | (unsigned)(a * 16 + bb));
                }
        cx[50] = -INFINITY; cx[51] = -INFINITY;
#pragma unroll
        for (int m = 0; m < 13; ++m) {
            const float x = fq == 0 ? cx[4 * m] : fq == 1 ? cx[4 * m + 1] : fq == 2 ? cx[4 * m + 2] : cx[4 * m + 3];
            INSERT16(best, x);
        }
    }
    MERGE16_XOR(best, 16);
    MERGE16_XOR(best, 32);
    float sum = 0.f;
#pragma unroll
    for (int i = 0; i < 16; ++i) sum += __expf(best[i] - best[0]);
    const float inv = 1.0f / sum, b0 = best[0];
    if (fq == 0) {
#pragma unroll
        for (int i = 0; i < 16; ++i) { sL[fr * 48 + i] = vtop[0][i]; sL[fr * 48 + 16 + i] = vtop[1][i]; sL[fr * 48 + 32 + i] = best[i]; }
    }
    int* PI = (int*)(p.ws + OFF_PIDX) + tok * 128 + h * 16 + 4 * fq;
    float* PG = (float*)(p.ws + OFF_PGATE) + tok * 128 + h * 16 + 4 * fq;
    int oi[4]; float og[4];
#pragma unroll
    for (int r = 0; r < 4; ++r) {
        const float bv = sL[fr * 48 + 32 + 4 * fq + r];
        const unsigned ab = __float_as_uint(bv) & 0xFFu;
        const unsigned e1 = __float_as_uint(sL[fr * 48 + (ab >> 4)]) & 0x7Fu;
        const unsigned e2 = __float_as_uint(sL[fr * 48 + 16 + (ab & 15u)]) & 0x7Fu;
        oi[r] = (int)(e1 * 128u + e2);
        og[r] = __expf(bv - b0) * inv;
    }
    const float* SVt = (const float*)(p.ws + OFF_SV);
    const float* SUt = (const float*)(p.ws + OFF_SU);
    float su[4];
#pragma unroll
    for (int r = 0; r < 4; ++r) { og[r] *= SVt[oi[r]]; su[r] = SUt[oi[r]]; }
    *(int4*)PI = make_int4(oi[0], oi[1], oi[2], oi[3]);
    *(float4*)PG = make_float4(og[0], og[1], og[2], og[3]);
    *(float4*)((float*)(p.ws + OFF_PSU) + tok * 128 + h * 16 + 4 * fq) = make_float4(su[0], su[1], su[2], su[3]);
}

typedef int i32x8 __attribute__((ext_vector_type(8)));
__device__ void peer_u_phase(const Params& p, unsigned char* smem) {
    int tid_ = TIDX; asm volatile("" : "+v"(tid_)); const int tid = tid_, lane = tid & 63, wave = __builtin_amdgcn_readfirstlane(tid >> 6), fr = lane & 15, fq = lane >> 4;
    const int s4 = (int)(blockIdx.x & 3), th = (int)((blockIdx.x >> 2) & 1), rank = (int)(blockIdx.x >> 3) * 2 + HALFID, nr = (int)(gridDim.x >> 3) * 2;
    const int r8 = lane >> 3, l8 = lane & 7;
    unsigned char* sU = smem + wave * 16384;
    const unsigned char* EU4x = p.ws + OFF_EU4 + 16 * (l8 ^ r8);
    u16* PP = (u16*)(p.ws + OFF_PPRE) + (size_t)s4 * T_TOK * 128;
    const int tt0 = rank * 4 + wave, t_first = th * (T_TOK / 2) + tt0;
    int idxA_n = ((const int*)(p.ws + OFF_PIDX) + (size_t)t_first * 128)[lane], idxB_n = ((const int*)(p.ws + OFF_PIDX) + (size_t)t_first * 128)[64 + lane];
    uint4 h00_n, h01_n, h10_n, h11_n;
    {
        const unsigned char* hq = p.ws + OFF_H2Q + (size_t)t_first * DM + 256 * s4 + 16 * fq;
        h00_n = *(const uint4*)hq; h01_n = *(const uint4*)(hq + 64); h10_n = *(const uint4*)(hq + 128); h11_n = *(const uint4*)(hq + 192);
    }
    for (int tt = tt0; tt < T_TOK / 2; tt += nr * 4) {
        const int t = th * (T_TOK / 2) + tt;
        const int idxA = idxA_n, idxB = idxB_n;
        const uint4 h00 = h00_n, h01 = h01_n, h10 = h10_n, h11 = h11_n;
        {
            const int tn = th * (T_TOK / 2) + min(tt + nr * 4, T_TOK / 2 - 1);
            const int* PIn = (const int*)(p.ws + OFF_PIDX) + (size_t)tn * 128;
            idxA_n = PIn[lane]; idxB_n = PIn[64 + lane];
            const unsigned char* hq = p.ws + OFF_H2Q + (size_t)tn * DM + 256 * s4 + 16 * fq;
            h00_n = *(const uint4*)hq; h01_n = *(const uint4*)(hq + 64); h10_n = *(const uint4*)(hq + 128); h11_n = *(const uint4*)(hq + 192);
        }
        const i32x8 b0 = {(int)h00.x, (int)h00.y, (int)h00.z, (int)h00.w, (int)h01.x, (int)h01.y, (int)h01.z, (int)h01.w};
        const i32x8 b1 = {(int)h10.x, (int)h10.y, (int)h10.z, (int)h10.w, (int)h11.x, (int)h11.y, (int)h11.z, (int)h11.w};
#pragma unroll
        for (int m = 0; m < 16; ++m) {
            const unsigned myidx = (unsigned)__builtin_amdgcn_ds_bpermute(((m & 7) * 8 + r8) << 2, m < 8 ? idxA : idxB);
            __builtin_amdgcn_global_load_lds((const unsigned*)(EU4x + (size_t)myidx * 512 + (((myidx + (unsigned)s4) & 3u) << 7)),
                                             (__attribute__((address_space(3))) unsigned*)(sU + m * 1024), 16, 0, 0);
        }
        asm volatile("s_waitcnt vmcnt(0)" ::: "memory");
        uint4 a0[8], a1[8];
#pragma unroll
        for (int eb = 0; eb < 8; ++eb) {
            const unsigned char* row = sU + (16 * eb + fr) * 128;
            a0[eb] = *(const uint4*)(row + ((fq ^ (fr & 7)) << 4)); a1[eb] = *(const uint4*)(row + (((4 + fq) ^ (fr & 7)) << 4));
        }
        f32x4 acc[8];
#pragma unroll
        for (int eb = 0; eb < 8; ++eb) {
            const i32x8 x0 = {(int)a0[eb].x, (int)a0[eb].y, (int)a0[eb].z, (int)a0[eb].w, 0, 0, 0, 0};
            acc[eb] = __builtin_amdgcn_mfma_scale_f32_16x16x128_f8f6f4(x0, b0, (f32x4){0.f, 0.f, 0.f, 0.f}, 4, 0, 0, 0x7F7F7F7F, 0, 0x7F7F7F7F);
        }
#pragma unroll
        for (int eb = 0; eb < 8; ++eb) {
            const i32x8 x1 = {(int)a1[eb].x, (int)a1[eb].y, (int)a1[eb].z, (int)a1[eb].w, 0, 0, 0, 0};
            acc[eb] = __builtin_amdgcn_mfma_scale_f32_16x16x128_f8f6f4(x1, b1, acc[eb], 4, 0, 0, 0x7F7F7F7F, 0, 0x7F7F7F7F);
        }
        f32x4 sel = acc[0];
#pragma unroll
        for (int eb = 1; eb < 8; ++eb) if ((fr & 7) == eb) sel = acc[eb];
        if (fr < 8) { uint2 w; w.x = pk_f16(sel[0], sel[1]); w.y = pk_f16(sel[2], sel[3]); *(uint2*)(PP + (size_t)t * 128 + 16 * fr + 4 * fq) = w; }
    }
}
__device__ void peer_combine_phase(const Params& p) {
    const u16* PP = (const u16*)(p.ws + OFF_PPRE);
    const float* PG = (const float*)(p.ws + OFF_PGATE);
    unsigned char* AWQ = p.ws + OFF_AW;
    for (size_t i = ((size_t)VBID * 256 + TIDX) * 4; i < (size_t)T_TOK * 128; i += (size_t)VGRID * 256 * 4) {
        float4 s = make_float4(0.f, 0.f, 0.f, 0.f);
#pragma unroll
        for (int c = 0; c < 4; ++c) {
            const uint2 w = *(const uint2*)(PP + (size_t)c * T_TOK * 128 + i);
            const f16x2 lo = __builtin_bit_cast(f16x2, w.x), hi = __builtin_bit_cast(f16x2, w.y);
            s.x += (float)lo.x; s.y += (float)lo.y; s.z += (float)hi.x; s.w += (float)hi.y;
        }
        const float4 g = *(const float4*)(PG + i);
        const float4 su = *(const float4*)((const float*)(p.ws + OFF_PSU) + i);
        const float rs16 = ((const float*)(p.ws + OFF_RS))[i >> 7] * (1.0f / 16.0f);
        const float pr[4] = {s.x * su.x * rs16, s.y * su.y * rs16, s.z * su.z * rs16, s.w * su.w * rs16};
        const float gg[4] = {g.x, g.y, g.z, g.w};
        float o[4];
#pragma unroll
        for (int r = 0; r < 4; ++r) o[r] = fminf(fmaxf(0.5f * pr[r] * (1.0f + erff(pr[r] * 0.70710678118654752f)) * gg[r] * 2048.0f, -448.0f), 448.0f);
        const unsigned hi = pk4_fp8(o[0], o[1], o[2], o[3]);
        const f32x2 d0 = __builtin_amdgcn_cvt_pk_f32_fp8((int)hi, false), d1 = __builtin_amdgcn_cvt_pk_f32_fp8((int)hi, true);
        const unsigned lo = pk4_fp8((o[0] - d0.x) * 16.0f, (o[1] - d0.y) * 16.0f, (o[2] - d1.x) * 16.0f, (o[3] - d1.y) * 16.0f);
        unsigned char* aq = AWQ + (i >> 7) * 256 + (i & 127);
        *(unsigned*)aq = hi; *(unsigned*)(aq + 128) = lo;
    }
}
__device__ __forceinline__ void axpy16_fp8(const float a, const uint4 v, float* acc) {
    const unsigned w[4] = {v.x, v.y, v.z, v.w};
#pragma unroll
    for (int e = 0; e < 4; ++e) {
        const f32x2 lo = __builtin_amdgcn_cvt_pk_f32_fp8((int)w[e], false), hi = __builtin_amdgcn_cvt_pk_f32_fp8((int)w[e], true);
        acc[4 * e + 0] += a * lo.x; acc[4 * e + 1] += a * lo.y; acc[4 * e + 2] += a * hi.x; acc[4 * e + 3] += a * hi.y;
    }
}
__device__ __forceinline__ void axpy32_fp4(const float a, const uint4 v, float* acc) {
    const unsigned w[4] = {v.x, v.y, v.z, v.w};
#pragma unroll
    for (int e = 0; e < 4; ++e) {
        const f32x2 d0 = __builtin_amdgcn_cvt_scalef32_pk_f32_fp4(w[e], 1.0f, 0), d1 = __builtin_amdgcn_cvt_scalef32_pk_f32_fp4(w[e], 1.0f, 1);
        const f32x2 d2 = __builtin_amdgcn_cvt_scalef32_pk_f32_fp4(w[e], 1.0f, 2), d3 = __builtin_amdgcn_cvt_scalef32_pk_f32_fp4(w[e], 1.0f, 3);
        acc[8 * e + 0] += a * d0.x; acc[8 * e + 1] += a * d0.y; acc[8 * e + 2] += a * d1.x; acc[8 * e + 3] += a * d1.y;
        acc[8 * e + 4] += a * d2.x; acc[8 * e + 5] += a * d2.y; acc[8 * e + 6] += a * d3.x; acc[8 * e + 7] += a * d3.y;
    }
}
typedef int i32x2v __attribute__((ext_vector_type(2)));
__device__ __forceinline__ i32x2v ld_tr4(const unsigned char* ptr) {
    return __builtin_amdgcn_ds_read_tr4_b64_v2i32((__attribute__((address_space(3))) i32x2v*)(ptr));
}
__device__ void peer_v_phase(const Params& p, unsigned char* smem) {
    int tid_ = TIDX; asm volatile("" : "+v"(tid_)); const int tid = tid_, lane = tid & 63, wave = __builtin_amdgcn_readfirstlane(tid >> 6), fr = lane & 15, fq = lane >> 4;
    const int s4 = (int)(blockIdx.x & 3), th = (int)((blockIdx.x >> 2) & 1), rank = (int)(blockIdx.x >> 3) * 2 + HALFID, nr = (int)(gridDim.x >> 3) * 2;
    const int r8 = lane >> 3, l8 = lane & 7;
    unsigned char* sV = smem + wave * 18432;
    const unsigned char* EV4 = p.ws + OFF_EV4 + 16 * l8;
    const int scale_b = (fr & 1) ? 0x70707070 : 0x74747474;
    const int tt0 = rank * 4 + wave, t_first = th * (T_TOK / 2) + tt0;
    int idxA_n = ((const int*)(p.ws + OFF_PIDX) + (size_t)t_first * 128)[lane], idxB_n = ((const int*)(p.ws + OFF_PIDX) + (size_t)t_first * 128)[64 + lane];
    const u16* PPb = (const u16*)(p.ws + OFF_PPRE);
    const float* PGb = (const float*)(p.ws + OFF_PGATE);
    const float* PSb = (const float*)(p.ws + OFF_PSU);
    const float* RSb = (const float*)(p.ws + OFF_RS);
    unsigned char* sW = smem + 4 * 18432 + wave * 256;
#define PV_FETCH(tq) { const size_t e_ = (size_t)(tq) * 128 + 2 * lane; \
        pp0_n = *(const unsigned*)(PPb + e_); pp1_n = *(const unsigned*)(PPb + (size_t)T_TOK * 128 + e_); pp2_n = *(const unsigned*)(PPb + (size_t)2 * T_TOK * 128 + e_); pp3_n = *(const unsigned*)(PPb + (size_t)3 * T_TOK * 128 + e_); \
        pg_n = *(const float2*)(PGb + e_); ps_n = *(const float2*)(PSb + e_); rs_n = RSb[tq]; }
    unsigned pp0_n, pp1_n, pp2_n, pp3_n; float2 pg_n, ps_n; float rs_n;
    PV_FETCH(t_first)
    for (int tt = tt0; tt < T_TOK / 2; tt += nr * 4) {
        const int t = th * (T_TOK / 2) + tt;
        const int idxA = idxA_n, idxB = idxB_n;
        const unsigned pp0 = pp0_n, pp1 = pp1_n, pp2 = pp2_n, pp3 = pp3_n; const float2 pg = pg_n, ps = ps_n; const float rs16 = rs_n * (1.0f / 16.0f);
        {
            const int tn = th * (T_TOK / 2) + min(tt + nr * 4, T_TOK / 2 - 1);
            const int* PIn = (const int*)(p.ws + OFF_PIDX) + (size_t)tn * 128;
            idxA_n = PIn[lane]; idxB_n = PIn[64 + lane];
            PV_FETCH(tn)
        }
        uint4 w0, w1;
        {
            const f16x2 a0 = __builtin_bit_cast(f16x2, pp0), a1 = __builtin_bit_cast(f16x2, pp1), a2 = __builtin_bit_cast(f16x2, pp2), a3 = __builtin_bit_cast(f16x2, pp3);
            const float pr0 = ((float)a0.x + (float)a1.x + (float)a2.x + (float)a3.x) * ps.x * rs16, pr1 = ((float)a0.y + (float)a1.y + (float)a2.y + (float)a3.y) * ps.y * rs16;
            const float o0 = fminf(fmaxf(0.5f * pr0 * (1.0f + erff(pr0 * 0.70710678118654752f)) * pg.x * 2048.0f, -448.0f), 448.0f);
            const float o1 = fminf(fmaxf(0.5f * pr1 * (1.0f + erff(pr1 * 0.70710678118654752f)) * pg.y * 2048.0f, -448.0f), 448.0f);
            const int hi = __builtin_amdgcn_cvt_pk_fp8_f32(o0, o1, 0, false);
            const f32x2 dh = __builtin_amdgcn_cvt_pk_f32_fp8(hi, false);
            const int lo = __builtin_amdgcn_cvt_pk_fp8_f32((o0 - dh.x) * 16.0f, (o1 - dh.y) * 16.0f, 0, false);
            *(u16*)(sW + 2 * lane) = (u16)(hi & 0xffff); *(u16*)(sW + 128 + 2 * lane) = (u16)(lo & 0xffff);
            const unsigned char* aq = sW + (fr & 1) * 128 + 16 * fq;
            w0 = *(const uint4*)aq; w1 = *(const uint4*)(aq + 64);
        }
        const uint2 x1w = *(const uint2*)((const u16*)(p.ws + OFF_X1B) + (size_t)t * DM + 256 * s4 + 4 * lane);
        const float4 x1 = make_float4(__uint_as_float(x1w.x << 16), __uint_as_float(x1w.x & 0xffff0000u), __uint_as_float(x1w.y << 16), __uint_as_float(x1w.y & 0xffff0000u));
        const i32x8 bw = {(int)w0.x, (int)w0.y, (int)w0.z, (int)w0.w, (int)w1.x, (int)w1.y, (int)w1.z, (int)w1.w};
        uint4 ua[16];
#pragma unroll
        for (int m = 0; m < 16; ++m) {
            const unsigned myidx = (unsigned)__builtin_amdgcn_ds_bpermute(((m & 7) * 8 + r8) << 2, m < 8 ? idxA : idxB);
            ua[m] = *(const uint4*)(EV4 + (size_t)myidx * 512 + (((myidx + (unsigned)s4) & 3u) << 7));
        }
#pragma unroll
        for (int m = 0; m < 16; ++m)
            *(uint4*)(sV + (8 * m + r8) * 144 + (l8 << 4)) = ((m >> 2) & 1) ? make_uint4(ua[m].z, ua[m].w, ua[m].x, ua[m].y) : ua[m];
        const unsigned char* row0 = sV + (32 * fq + fr) * 144;
        i32x2v q0[16], q1[16];
#pragma unroll
        for (int m = 0; m < 16; ++m) { const int off = 8 * (m ^ (fq & 1)); q0[m] = ld_tr4(row0 + off); q1[m] = ld_tr4(row0 + 16 * 144 + off); }
        f32x4 acc[16];
#pragma unroll
        for (int m = 0; m < 16; ++m) {
            const i32x8 av = {q0[m].x, q0[m].y, q1[m].x, q1[m].y, 0, 0, 0, 0};
            acc[m] = __builtin_amdgcn_mfma_scale_f32_16x16x128_f8f6f4(av, bw, (f32x4){0.f, 0.f, 0.f, 0.f}, 4, 0, 0, 0x7F7F7F7F, 0, scale_b);
        }
        f32x4 s0 = acc[0], s1 = acc[1];
#pragma unroll
        for (int k = 1; k < 8; ++k) if ((fr >> 1) == k) { s0 = acc[2 * k]; s1 = acc[2 * k + 1]; }
#pragma unroll
        for (int r = 0; r < 4; ++r) {
            s0[r] += __int_as_float(__builtin_amdgcn_update_dpp(0, __float_as_int(s0[r]), 0xB1, 0xF, 0xF, true));
            s1[r] += __int_as_float(__builtin_amdgcn_update_dpp(0, __float_as_int(s1[r]), 0xB1, 0xF, 0xF, true));
        }
        {
            const int m0 = 2 * (fr >> 1);
            *(float4*)(sV + (4 * m0 + fq) * 144 + 128) = make_float4(s0[0], s0[1], s0[2], s0[3]);
            *(float4*)(sV + (4 * (m0 + 1) + fq) * 144 + 128) = make_float4(s1[0], s1[1], s1[2], s1[3]);
        }
        const float4 o0 = *(const float4*)(sV + lane * 144 + 128);
        {
            const f32x4 ov = {x1.x + o0.x, x1.y + o0.y, x1.z + o0.z, x1.w + o0.w};
            __builtin_nontemporal_store(ov, (f32x4*)(p.out + (size_t)t * DM + 256 * s4 + 4 * lane));
        }
    }
}

typedef unsigned u32x4v __attribute__((ext_vector_type(4)));
__device__ void qgemm_fp8(const Params& p, LAS unsigned char* lds) {
    int tid_ = threadIdx.x; asm volatile("" : "+v"(tid_)); const int tid = tid_, lane = tid & 63, wave = __builtin_amdgcn_readfirstlane(tid >> 6), fr = lane & 15, fq = lane >> 4;
    const int r8 = lane >> 3, l8 = lane & 7, wr = wave >> 2, wc = wave & 3;
    const unsigned char* A = p.ws + OFF_H2Q;
    const unsigned char* W = p.ws + OFF_WT_Q;
    const int x = (int)(blockIdx.x & 7), lb = (int)(blockIdx.x >> 3), nlb = (int)(gridDim.x >> 3);
    const int ntile = lb >= 128 ? 0 : (128 - lb + nlb - 1) / nlb;
#define QG_LT(ti) (lb + (ti) * nlb)
    const int nstage = ntile * 8;
    LAS float* sRs = (LAS float*)(lds + 131072);
    for (int e = tid; e < ntile * 256; e += 512) {
        const int lt = QG_LT(e >> 8), row = (x + 8 * (lt >> 3)) * 256 + (e & 255);
        const float* ssp = (const float*)(p.ws + OFF_SSP);
        float ss = 0.f;
#pragma unroll
        for (int j = 0; j < 16; ++j) ss += ssp[(size_t)j * 32768 + row];
        const float rs = rsqrtf(ss * (1.0f / 1024.0f) + 1e-6f);
        sRs[e] = rs;
        if ((lt & 7) == 0) ((float*)(p.ws + OFF_RS))[row] = rs;
    }
    const unsigned swz = (unsigned)((l8 ^ r8) << 4);
    const int wperm = 16 * (r8 >> 2) + (r8 & 3);
#define QG_DMA(s_) { const int ti_ = (s_) >> 3, kt_ = (s_) & 7, lt_ = QG_LT(ti_); const int pm_ = x + 8 * (lt_ >> 3), pn_ = lt_ & 7; \
        LAS unsigned char* sb_ = lds + ((s_) & 1) * 65536; \
        _Pragma("unroll") for (int i_ = 0; i_ < 4; ++i_) { const int g_ = i_ * 8 + wave; \
            __builtin_amdgcn_global_load_lds((const unsigned*)(A + (size_t)(pm_ * 256 + g_ * 8 + r8) * 1024 + kt_ * 128 + swz), (LAS unsigned*)(sb_ + g_ * 1024), 16, 0, 0); \
            __builtin_amdgcn_global_load_lds((const unsigned*)(W + (size_t)(pn_ * 256 + (g_ >> 3) * 64 + (g_ & 1) * 32 + ((g_ >> 1) & 3) * 4 + wperm) * 1024 + kt_ * 128 + swz), (LAS unsigned*)(sb_ + 32768 + g_ * 1024), 16, 0, 0); } }
    f32x4 acc[8][4];
#pragma unroll
    for (int m = 0; m < 8; ++m)
#pragma unroll
        for (int n = 0; n < 4; ++n) acc[m][n] = (f32x4){0.f, 0.f, 0.f, 0.f};
    if (nstage > 0) QG_DMA(0)
    asm volatile("s_waitcnt vmcnt(0)" ::: "memory");
    __syncthreads();
    const int c0 = (fq ^ (fr & 7)) << 4, c1 = ((4 + fq) ^ (fr & 7)) << 4;
    const unsigned lbase = (unsigned)(uintptr_t)lds;
    for (int s = 0; s < nstage; ++s) {
        if (s + 1 < nstage) QG_DMA(s + 1)
        const unsigned sa = lbase + (s & 1) * 65536 + (wr * 128 + fr) * 128, sb = lbase + (s & 1) * 65536 + 32768 + (wc * 64 + fr) * 128;
#define QG_RD(dst, addr) asm volatile("ds_read_b128 %0, %1" : "=v"(dst) : "v"(addr) : "memory")
#define QG_WAIT8(v) asm volatile("s_waitcnt lgkmcnt(0)" : "+v"(v[0]), "+v"(v[1]), "+v"(v[2]), "+v"(v[3]), "+v"(v[4]), "+v"(v[5]), "+v"(v[6]), "+v"(v[7]))
        u32x4v bq[8], a0q[8], a1q[8];
#pragma unroll
        for (int n = 0; n < 4; ++n) { QG_RD(bq[2 * n], sb + n * 2048 + c0); QG_RD(bq[2 * n + 1], sb + n * 2048 + c1); }
#pragma unroll
        for (int m = 0; m < 4; ++m) { QG_RD(a0q[2 * m], sa + m * 2048 + c0); QG_RD(a0q[2 * m + 1], sa + m * 2048 + c1); }
        QG_WAIT8(bq); QG_WAIT8(a0q);
#pragma unroll
        for (int m = 0; m < 4; ++m) { QG_RD(a1q[2 * m], sa + (4 + m) * 2048 + c0); QG_RD(a1q[2 * m + 1], sa + (4 + m) * 2048 + c1); }
        i32x8 bf[4];
#pragma unroll
        for (int n = 0; n < 4; ++n) bf[n] = (i32x8){(int)bq[2 * n][0], (int)bq[2 * n][1], (int)bq[2 * n][2], (int)bq[2 * n][3], (int)bq[2 * n + 1][0], (int)bq[2 * n + 1][1], (int)bq[2 * n + 1][2], (int)bq[2 * n + 1][3]};
#pragma unroll
        for (int m = 0; m < 4; ++m) {
            const i32x8 af = {(int)a0q[2 * m][0], (int)a0q[2 * m][1], (int)a0q[2 * m][2], (int)a0q[2 * m][3], (int)a0q[2 * m + 1][0], (int)a0q[2 * m + 1][1], (int)a0q[2 * m + 1][2], (int)a0q[2 * m + 1][3]};
#pragma unroll
            for (int n = 0; n < 4; ++n) acc[m][n] = __builtin_amdgcn_mfma_scale_f32_16x16x128_f8f6f4(bf[n], af, acc[m][n], 0, 0, 0, 0x7F7F7F7F, 0, 0x7F7F7F7F);
        }
        QG_WAIT8(a1q);
#pragma unroll
        for (int m = 0; m < 4; ++m) {
            const i32x8 af = {(int)a1q[2 * m][0], (int)a1q[2 * m][1], (int)a1q[2 * m][2], (int)a1q[2 * m][3], (int)a1q[2 * m + 1][0], (int)a1q[2 * m + 1][1], (int)a1q[2 * m + 1][2], (int)a1q[2 * m + 1][3]};
#pragma unroll
            for (int n = 0; n < 4; ++n) acc[4 + m][n] = __builtin_amdgcn_mfma_scale_f32_16x16x128_f8f6f4(bf[n], af, acc[4 + m][n], 0, 0, 0, 0x7F7F7F7F, 0, 0x7F7F7F7F);
        }
#undef QG_RD
#undef QG_WAIT8
        asm volatile("s_waitcnt vmcnt(0)" ::: "memory");
        if ((s & 7) == 7) {
            const int ti = s >> 3, lt = QG_LT(ti), pm = x + 8 * (lt >> 3), pn = lt & 7;
            u16* QP = (u16*)(p.ws + OFF_QP);
#pragma unroll
            for (int m = 0; m < 8; ++m) {
                const int row = pm * 256 + wr * 128 + m * 16 + fr;
                const float sc = sRs[ti * 256 + wr * 128 + m * 16 + fr] * (1.0f / (16.0f * SWQ));
                unsigned ow[8];
#pragma unroll
                for (int n = 0; n < 4; ++n) {
                    ow[2 * n] = pk_f16(acc[m][n][0] * sc, acc[m][n][1] * sc); ow[2 * n + 1] = pk_f16(acc[m][n][2] * sc, acc[m][n][3] * sc);
                    acc[m][n] = (f32x4){0.f, 0.f, 0.f, 0.f};
                }
                u16* orow = QP + (size_t)row * 2048 + pn * 256 + wc * 64 + 16 * fq;
                *(uint4*)orow = make_uint4(ow[0], ow[1], ow[2], ow[3]);
                *(uint4*)(orow + 8) = make_uint4(ow[4], ow[5], ow[6], ow[7]);
            }
        }
        __syncthreads();
    }
#undef QG_DMA
}

#define N_PHASES 12
__global__ void __launch_bounds__(512, 2) hymba_mega(const Params p, const int ph_lo, const int ph_hi) {
    extern __shared__ __attribute__((aligned(16))) unsigned char smem_all[];
    unsigned char* smem = smem_all + (threadIdx.x >> 8) * SMEM_HALF;
    const int G = VGRID, bid = VBID;
#ifndef PH_ONLY
#define PH_ONLY -1
#endif
#ifndef REP_PH
#define REP_PH -1
#endif
#define PH_RUN(k) ((PH_ONLY < 0 || PH_ONLY == (k)) && ph_lo <= (k) && (k) <= ph_hi)
#define PH_REPS(k) ((REP_PH == (k)) ? 2 : 1)
#define PH_SYNC(k) do { if ((k) < ph_hi && (k) >= ph_lo) { XcdBarrier xb_; xb_.bar = (unsigned*)(p.ws + OFF_BAR); xb_.x = xb_xcc_id(); xb_.st = (volatile unsigned*)&xb_words; xcd_barrier(xb_); } } while (0)
    __shared__ uint4 xb_words;
    if (threadIdx.x == 0) xb_words = make_uint4(0u, 0u, 0u, 0u);
    __syncthreads();
    (void)xcd_barrier_post((unsigned*)(p.ws + OFF_BAR), (volatile unsigned*)&xb_words);
    if (PH_RUN(0)) for (int rep = 0; rep < PH_REPS(0); ++rep) phase0(p, smem);
    PH_SYNC(0);
    if (PH_RUN(1)) for (int rep = 0; rep < PH_REPS(1); ++rep) {
        pg8::Gemm g{(const u16*)(p.ws + OFF_H1), (const u16*)(p.ws + OFF_WT_IN), T_TOK, 3072, 1024}; pg8::StaticOrder S; S.init(T_TOK, 3072, (int)gridDim.x, (int)blockIdx.x);
        pg8::EpiBf16<0> E{(u16*)(p.ws + OFF_R1), 512, nullptr, 512, (size_t)16 * MIB, 1.0f};
        pg8::gemm_phase<pg8::EpiBf16<0>, pg8::StaticOrder, true, true>((PG8_LAS unsigned char*)smem_all, g, S, E);
    }
    PH_SYNC(1);
    if (PH_RUN(2)) for (int rep = 0; rep < PH_REPS(2); ++rep)
        { for (int t = bid; t < 1024; t += G) mlstm_local(p, t, smem); __syncthreads(); attn_phase(p, smem_all); }
    PH_SYNC(2);
    if (PH_RUN(3)) for (int rep = 0; rep < PH_REPS(3); ++rep) {
        for (int t = bid; t < P3_ITEMS; t += G) scan_item(p, t);
        if (bid >= 16) for (int t = bid - 16; t < 2048; t += G - 16) phase6_item(p, P6_ROWITEMS + t);
    }
    PH_SYNC(3);
    if (PH_RUN(4)) for (int rep = 0; rep < PH_REPS(4); ++rep)
        { for (int t = bid; t < 1024; t += G) mlstm_out(p, t, smem); for (int t = bid; t < 8192; t += 4 * G) attn_combine4(p, t, G); }
    PH_SYNC(4);
    if (PH_RUN(5)) for (int rep = 0; rep < PH_REPS(5); ++rep) {
        pg8::Gemm g{(const u16*)(p.ws + OFF_Y), (const u16*)(p.ws + OFF_WT_OUT), T_TOK, 1024, 1024}; pg8::StaticOrder S; S.init(T_TOK, 1024, (int)gridDim.x, (int)blockIdx.x);
        pg8::EpiResX1 E{p.x, (u16*)(p.ws + OFF_X1B), p.ws + OFF_H2Q, p.norm2_g, (float*)(p.ws + OFF_SSP), 1024};
        pg8::gemm_phase<pg8::EpiResX1, pg8::StaticOrder, true, true>((PG8_LAS unsigned char*)smem_all, g, S, E);
    }
    PH_SYNC(5);
    if (PH_RUN(7)) for (int rep = 0; rep < PH_REPS(7); ++rep) qgemm_fp8(p, (LAS unsigned char*)smem_all);
    PH_SYNC(7);
    if (PH_RUN(8)) for (int rep = 0; rep < PH_REPS(8); ++rep)
        { peer_score_stage(p, bid & 7, smem); for (int t = bid; t < 512 * 8; t += G) peer_score(p, t, smem); __syncthreads(); }
    PH_SYNC(8);
    if (PH_RUN(9)) for (int rep = 0; rep < PH_REPS(9); ++rep) peer_u_phase(p, smem);
    PH_SYNC(9);
    if (PH_RUN(11)) for (int rep = 0; rep < PH_REPS(11); ++rep) peer_v_phase(p, smem);
}


extern "C" void kernel_launch(void* const* d_in, const int* in_sizes, int n_in, void* d_out, int out_size, void* d_ws, size_t ws_size, hipStream_t stream) {
    (void)in_sizes; (void)n_in; (void)out_size;
    if (ws_size < WS_NEEDED) { fprintf(stderr, "workspace too small: %zu < %zu\n", ws_size, (size_t)WS_NEEDED); return; }
    static int grid_blocks = 0;
    if (!grid_blocks) {
        int dev = 0, cus = 0, per_cu = 0;
        (void)hipGetDevice(&dev);
        (void)hipDeviceGetAttribute(&cus, hipDeviceAttributeMultiprocessorCount, dev);
        if (hipFuncSetAttribute((const void*)hymba_mega, hipFuncAttributeMaxDynamicSharedMemorySize, 2 * SMEM_HALF) != hipSuccess) fprintf(stderr, "hipFuncSetAttribute failed\n");
        (void)hipOccupancyMaxActiveBlocksPerMultiprocessor(&per_cu, hymba_mega, 512, 2 * SMEM_HALF);
        if (per_cu > 1) per_cu = 1;
        if (per_cu < 1) per_cu = 1;
        grid_blocks = cus * per_cu;
    }
    Params p{};
    const float* const* in = (const float* const*)d_in;
    p.x = in[0]; p.norm1_g = in[1]; p.w_in = in[2]; p.conv_w = in[3]; p.conv_b = in[4]; p.wq_m = in[5]; p.wk_m = in[6]; p.ig_b = in[7]; p.fg_b = in[8];
    p.mh_norm_g = in[9]; p.skip_m = in[10]; p.qn_g = in[11]; p.kn_g = in[12]; p.rel_bias = in[13]; p.w_out = in[14]; p.norm2_g = in[15]; p.w_query = in[16];
    p.sub_keys1 = in[17]; p.sub_keys2 = in[18]; p.expert_u = in[19]; p.expert_v = in[20];
    p.out = (float*)d_out; p.ws = (unsigned char*)d_ws;
    (void)hipMemsetAsync((unsigned char*)d_ws + OFF_BAR, 0, XCD_BAR_WORDS * sizeof(unsigned), stream);
    int lo = 0, hi = N_PHASES - 1;
    void* args[] = {(void*)&p, (void*)&lo, (void*)&hi};
    hipError_t e = hipLaunchCooperativeKernel((const void*)hymba_mega, dim3(grid_blocks), dim3(512), args, 2 * SMEM_HALF, stream);
    if (e != hipSuccess) fprintf(stderr, "cooperative launch failed: %s (grid %d)\n", hipGetErrorString(e), grid_blocks);
}
```
